# Optimizing an MI355X kernel written in HIP

```python
import jax
import jax.numpy as jnp
from jax import lax
import numpy as np

D_MODEL = 1024
BATCH = 2
SEQ = 8192
DEPTH = 1

MOBA_HEADS = 8
MOBA_HEAD_DIM = 128
MOBA_WIDTH = MOBA_HEADS * MOBA_HEAD_DIM
MOBA_BLOCK = 256
MOBA_TOPK = 3
MOBA_QCHUNK = 32
ROPE_DIM = MOBA_HEAD_DIM // 4
ROPE_THETA = 500000.0

GLA_HEADS = 4
GLA_KEY_DIM = D_MODEL // 2
GLA_VAL_DIM = D_MODEL
GLA_DK = GLA_KEY_DIM // GLA_HEADS
GLA_DV = GLA_VAL_DIM // GLA_HEADS
GLA_GATE_RANK = 16
GLA_GATE_NORMALIZER = 16.0
GLA_CHUNK = 64

N_EXPERTS = 32
TOP_K = 4
D_EXPERT = D_MODEL
SWIGLU_ALPHA = 1.702
SWIGLU_LIMIT = 7.0
EXPERT_ROW_BLOCK = 128

RMS_EPS = 1e-5
N_BRANCHES = 2
IN_SPLITS = (MOBA_WIDTH, MOBA_WIDTH, MOBA_WIDTH, GLA_KEY_DIM, GLA_KEY_DIM, GLA_VAL_DIM, GLA_VAL_DIM, GLA_GATE_RANK, D_MODEL, D_MODEL)
N_IN = 3 * MOBA_WIDTH + 2 * GLA_KEY_DIM + 2 * GLA_VAL_DIM + GLA_GATE_RANK + N_BRANCHES * D_MODEL

kernel_name = "hybrid_moba_gla_moe_adaln_block"


def _rmsnorm(x, w):
    xf = x.astype(jnp.float32)
    y = xf * lax.rsqrt(jnp.mean(xf * xf, axis=-1, keepdims=True) + RMS_EPS)
    return (y * w.astype(jnp.float32)).astype(x.dtype)


def _partial_rope(x):
    S = x.shape[1]
    half = ROPE_DIM // 2
    inv_freq = jnp.float32(ROPE_THETA) ** (-jnp.arange(half, dtype=jnp.float32) * 2.0 / ROPE_DIM)
    ang = jnp.arange(S, dtype=jnp.float32)[:, None] * inv_freq[None, :]
    cos = jnp.cos(ang)[None, :, None, :]
    sin = jnp.sin(ang)[None, :, None, :]
    xr = x[..., :ROPE_DIM].astype(jnp.float32)
    x1, x2 = xr[..., :half], xr[..., half:]
    rot = jnp.concatenate([x1 * cos - x2 * sin, x2 * cos + x1 * sin], axis=-1).astype(x.dtype)
    return jnp.concatenate([rot, x[..., ROPE_DIM:]], axis=-1)


def _moba_attention(q, k, v):
    B, S, H, Dh = q.shape
    n_blocks = -(-S // MOBA_BLOCK)
    s_pad = n_blocks * MOBA_BLOCK
    topk = min(MOBA_TOPK, n_blocks)
    scale = Dh ** -0.5

    def prep(t):
        t = jnp.pad(t, ((0, 0), (0, s_pad - S), (0, 0), (0, 0)))
        return t.transpose(0, 2, 1, 3)

    qh, kh, vh = prep(q), prep(k), prep(v)
    kb = kh.reshape(B, H, n_blocks, MOBA_BLOCK, Dh)
    vb = vh.reshape(B, H, n_blocks, MOBA_BLOCK, Dh)
    k_mean = jnp.mean(kb.astype(jnp.float32), axis=3)
    b_idx = jnp.arange(B)[:, None, None, None]
    h_idx = jnp.arange(H)[None, :, None, None]
    block_ids = jnp.arange(n_blocks)

    def query_chunk(ci):
        start = ci * MOBA_QCHUNK
        blk = start // MOBA_BLOCK
        qc = lax.dynamic_slice_in_dim(qh, start, MOBA_QCHUNK, axis=2)
        gate = jnp.einsum('bhqd,bhnd->bhqn', qc.astype(jnp.float32), k_mean)
        gate = jnp.where(block_ids < blk, gate, -jnp.inf)
        _, sel = lax.top_k(gate, topk)
        valid = sel < blk
        k_sel = kb[b_idx, h_idx, sel]
        v_sel = vb[b_idx, h_idx, sel]
        s_sel = jnp.einsum('bhqd,bhqnkd->bhqnk', qc, k_sel).astype(jnp.float32) * scale
        s_sel = jnp.where(valid[..., None], s_sel, -jnp.inf).reshape(B, H, MOBA_QCHUNK, topk * MOBA_BLOCK)
        k_own = lax.dynamic_index_in_dim(kb, blk, axis=2, keepdims=False)
        v_own = lax.dynamic_index_in_dim(vb, blk, axis=2, keepdims=False)
        s_own = jnp.einsum('bhqd,bhkd->bhqk', qc, k_own).astype(jnp.float32) * scale
        q_pos = start + jnp.arange(MOBA_QCHUNK)
        k_pos = blk * MOBA_BLOCK + jnp.arange(MOBA_BLOCK)
        s_own = jnp.where(k_pos[None, :] <= q_pos[:, None], s_own, -jnp.inf)
        p = jax.nn.softmax(jnp.concatenate([s_sel, s_own], axis=-1), axis=-1).astype(vh.dtype)
        p_sel = p[..., :topk * MOBA_BLOCK].reshape(B, H, MOBA_QCHUNK, topk, MOBA_BLOCK)
        p_own = p[..., topk * MOBA_BLOCK:]
        return (jnp.einsum('bhqnk,bhqnkd->bhqd', p_sel, v_sel)
                + jnp.einsum('bhqk,bhkd->bhqd', p_own, v_own))

    out = lax.map(query_chunk, jnp.arange(s_pad // MOBA_QCHUNK))
    out = out.transpose(1, 0, 3, 2, 4).reshape(B, s_pad, H, Dh)
    return out[:, :S]


def _gla_chunked(q, k, v, log_g):
    B, S, H, dk = q.shape
    dv = v.shape[-1]
    n_chunks = S // GLA_CHUNK

    def to_chunks(t):
        t = t.astype(jnp.float32).reshape(B, n_chunks, GLA_CHUNK, H, t.shape[-1])
        return t.transpose(1, 0, 3, 2, 4)

    qc = to_chunks(q) * (dk ** -0.5)
    kc, vc, gc = to_chunks(k), to_chunks(v), to_chunks(log_g)
    causal = jnp.tril(jnp.ones((GLA_CHUNK, GLA_CHUNK), dtype=bool))[:, :, None]

    def step(state, inp):
        qi, ki, vi, gi = inp
        b = jnp.cumsum(gi, axis=2)
        b_last = b[:, :, -1:, :]
        o_inter = jnp.einsum('bhcd,bhdv->bhcv', qi * jnp.exp(b), state)
        diff = b[:, :, :, None, :] - b[:, :, None, :, :]
        decay = jnp.exp(jnp.where(causal, diff, -jnp.inf))
        scores = jnp.einsum('bhid,bhjd,bhijd->bhij', qi, ki, decay)
        o = o_inter + jnp.einsum('bhij,bhjv->bhiv', scores, vi)
        state = (state * jnp.exp(b_last[:, :, 0, :, None])
                 + jnp.einsum('bhcd,bhcv->bhdv', ki * jnp.exp(b_last - b), vi))
        return state, o

    state0 = jnp.zeros((B, H, dk, dv), jnp.float32)
    _, o = lax.scan(step, state0, (qc, kc, vc, gc))
    return o.transpose(1, 0, 3, 2, 4).reshape(B, S, H, dv)


def _mixer(h, w_in, gla_gate_w, gla_gate_b, gla_norm_w, w_o_moba, w_o_gla, b_merge, w_out):
    B, S, _ = h.shape
    proj = h @ w_in
    idx = []
    acc = 0
    for size in IN_SPLITS[:-1]:
        acc += size
        idx.append(acc)
    mq, mk, mv, gq, gk, gv, gr, g_low, gate_a, gate_b = jnp.split(proj, idx, axis=-1)

    def heads(t, n):
        return t.reshape(B, S, n, -1)

    mq = _partial_rope(heads(mq, MOBA_HEADS))
    mk = _partial_rope(heads(mk, MOBA_HEADS))
    o_a = _moba_attention(mq, mk, heads(mv, MOBA_HEADS)).reshape(B, S, MOBA_WIDTH)
    y_a = o_a @ w_o_moba

    log_g = jax.nn.log_sigmoid((g_low @ gla_gate_w + gla_gate_b).astype(jnp.float32)) / GLA_GATE_NORMALIZER
    o_b = _gla_chunked(heads(gq, GLA_HEADS), heads(gk, GLA_HEADS), heads(gv, GLA_HEADS), heads(log_g, GLA_HEADS))
    o_b = _rmsnorm(o_b, gla_norm_w) * jax.nn.silu(heads(gr, GLA_HEADS).astype(jnp.float32))
    y_b = o_b.reshape(B, S, GLA_VAL_DIM).astype(h.dtype) @ w_o_gla

    g_a = jax.nn.sigmoid(gate_a + b_merge[:D_MODEL])
    g_b = jax.nn.sigmoid(gate_b + b_merge[D_MODEL:])
    return (g_a * y_a + g_b * y_b) @ w_out


def _clamped_swiglu(h):
    x_glu = jnp.minimum(h[..., ::2], SWIGLU_LIMIT)
    x_lin = jnp.clip(h[..., 1::2], -SWIGLU_LIMIT, SWIGLU_LIMIT)
    return x_glu * jax.nn.sigmoid(SWIGLU_ALPHA * x_glu) * (x_lin + 1.0)


def _moe(h, w_router, b_router, w_exp_in, b_exp_in, w_exp_out, b_exp_out):
    B, S, D = h.shape
    T = B * S
    R = EXPERT_ROW_BLOCK
    tokens = h.reshape(T, D)
    logits = (tokens @ w_router + b_router).astype(jnp.float32)
    top_logits, top_idx = lax.top_k(logits, TOP_K)
    top_w = jax.nn.softmax(top_logits, axis=-1)
    flat_expert = top_idx.reshape(-1)
    flat_token = jnp.arange(T * TOP_K, dtype=jnp.int32) // TOP_K
    flat_w = top_w.reshape(-1)
    order = jnp.argsort(flat_expert)
    sorted_expert = flat_expert[order]
    counts = jax.ops.segment_sum(jnp.ones_like(flat_expert), flat_expert, num_segments=N_EXPERTS)
    group_start = jnp.cumsum(counts) - counts
    padded_counts = (counts + R - 1) // R * R
    padded_end = jnp.cumsum(padded_counts)
    padded_start = padded_end - padded_counts
    rank = jnp.arange(T * TOP_K, dtype=jnp.int32) - group_start[sorted_expert]
    dest = padded_start[sorted_expert] + rank
    n_row_blocks = -(-(T * TOP_K + N_EXPERTS * (R - 1)) // R)
    P = n_row_blocks * R
    row_token = jnp.zeros((P,), jnp.int32).at[dest].set(flat_token[order])
    row_weight = jnp.zeros((P,), jnp.float32).at[dest].set(flat_w[order])
    block_expert = jnp.minimum(
        jnp.searchsorted(padded_end, jnp.arange(n_row_blocks) * R, side='right'), N_EXPERTS - 1)

    def expert_block(j):
        rows = lax.dynamic_slice_in_dim(row_token, j * R, R)
        wts = lax.dynamic_slice_in_dim(row_weight, j * R, R)
        e = block_expert[j]
        hid = tokens[rows] @ w_exp_in[e] + b_exp_in[e]
        out = _clamped_swiglu(hid) @ w_exp_out[e] + b_exp_out[e]
        return out * wts[:, None].astype(out.dtype)

    out = lax.map(expert_block, jnp.arange(n_row_blocks)).reshape(P, D)
    y = jnp.zeros((T, D), out.dtype).at[row_token].add(out)
    return y.reshape(B, S, D)


def setup_inputs(seed: int = 0) -> dict:
    key = jax.random.key(seed)
    ks = jax.random.split(key, 21)
    L = DEPTH

    def nrm(k, shape, scale):
        return jax.random.normal(k, shape, jnp.float32) * scale

    return {
        'x': nrm(ks[0], (BATCH, SEQ, D_MODEL), 1.0),
        'c': nrm(ks[1], (BATCH, D_MODEL), 1.0),
        'w_ada': nrm(ks[2], (L, D_MODEL, 6 * D_MODEL), 0.5 * D_MODEL ** -0.5),
        'b_ada': nrm(ks[3], (L, 6 * D_MODEL), 0.01),
        'norm1_w': 1.0 + nrm(ks[4], (L, D_MODEL), 0.01),
        'w_in': nrm(ks[5], (L, D_MODEL, N_IN), D_MODEL ** -0.5),
        'gla_gate_w': nrm(ks[6], (L, GLA_GATE_RANK, GLA_KEY_DIM), GLA_GATE_RANK ** -0.5),
        'gla_gate_b': nrm(ks[7], (L, GLA_KEY_DIM), 0.01),
        'gla_norm_w': 1.0 + nrm(ks[8], (L, GLA_DV), 0.01),
        'w_o_moba': nrm(ks[9], (L, MOBA_WIDTH, D_MODEL), MOBA_WIDTH ** -0.5),
        'w_o_gla': nrm(ks[10], (L, GLA_VAL_DIM, D_MODEL), GLA_VAL_DIM ** -0.5),
        'b_merge': nrm(ks[11], (L, N_BRANCHES * D_MODEL), 0.01),
        'w_out': nrm(ks[12], (L, D_MODEL, D_MODEL), D_MODEL ** -0.5),
        'norm2_w': 1.0 + nrm(ks[13], (L, D_MODEL), 0.01),
        'w_router': nrm(ks[14], (L, D_MODEL, N_EXPERTS), D_MODEL ** -0.5),
        'b_router': nrm(ks[15], (L, N_EXPERTS), 0.01),
        'w_exp_in': nrm(ks[16], (L, N_EXPERTS, D_MODEL, 2 * D_EXPERT), D_MODEL ** -0.5),
        'b_exp_in': nrm(ks[17], (L, N_EXPERTS, 2 * D_EXPERT), 0.01),
        'w_exp_out': nrm(ks[18], (L, N_EXPERTS, D_EXPERT, D_MODEL), D_EXPERT ** -0.5),
        'b_exp_out': nrm(ks[19], (L, N_EXPERTS, D_MODEL), 0.01),
        'final_norm_w': 1.0 + nrm(ks[20], (D_MODEL,), 0.01),
    }


def reference(x, c, w_ada, b_ada, norm1_w, w_in, gla_gate_w, gla_gate_b, gla_norm_w, w_o_moba, w_o_gla, b_merge, w_out, norm2_w, w_router, b_router, w_exp_in, b_exp_in, w_exp_out, b_exp_out, final_norm_w):
    c_act = jax.nn.silu(c)
    for l in range(DEPTH):
        mod = (c_act @ w_ada[l] + b_ada[l])[:, None, :]
        shift1, scale1, gate1, shift2, scale2, gate2 = jnp.split(mod, 6, axis=-1)
        h = _rmsnorm(x, norm1_w[l]) * (1.0 + scale1) + shift1
        x = x + gate1 * _mixer(h, w_in[l], gla_gate_w[l], gla_gate_b[l], gla_norm_w[l],
                               w_o_moba[l], w_o_gla[l], b_merge[l], w_out[l])
        h = _rmsnorm(x, norm2_w[l]) * (1.0 + scale2) + shift2
        x = x + gate2 * _moe(h, w_router[l], b_router[l], w_exp_in[l], b_exp_in[l],
                             w_exp_out[l], b_exp_out[l])
    return _rmsnorm(x, final_norm_w)
```

```cpp
#include <hip/hip_runtime.h>
#include <hip/hip_bf16.h>
#include <cstdio>
#include <cstdint>
#define LAS __attribute__((address_space(3)))
namespace pg8 {
#define PG8_LAS __attribute__((address_space(3)))
typedef unsigned short bf16_t;
typedef short bf16x8 __attribute__((ext_vector_type(8)));
typedef float f32x4 __attribute__((ext_vector_type(4)));
typedef unsigned u32x4 __attribute__((ext_vector_type(4)));
constexpr int BM = 256, BK = 64, HALF = 128, HTB = HALF * BK * 2  , STAGE_BYTES = 8 * HTB, NXCD = 8, WGM = 8;

__host__ __device__ __forceinline__ int lds_byte(int r, int c) { const int st = (r >> 4) * 2 + (c >> 5), rr = r & 15, cc = c & 31, ob = rr * 64 + cc * 2; return st * 1024 + (ob ^ (((ob >> 9) & 1) << 5)); }
__host__ __device__ __forceinline__ void stage_rc(int b, int& R, int& C) { const int st = b / 1024, sb = b % 1024, swz = sb ^ (((sb >> 9) & 1) << 5); R = (st >> 1) * 16 + swz / 64; C = (st & 1) * 32 + (swz % 64) / 2; }
__host__ __device__ __forceinline__ int perm32(int rho) { const int n = rho >> 4, i = rho & 15; return 8 * (i >> 2) + 4 * n + (i & 3); }

struct Unit { int pm, pn, e; };
struct Gemm { const bf16_t* A; const bf16_t* Bt; int M, N, K; };

struct StaticOrder {
    int nM, nN, nwg, G, c;
    __host__ __device__ void init(int M, int N, int G_, int c_) { nM = M / BM; nN = N / BM; nwg = nM * nN; G = G_; c = c_; }
    __host__ __device__ bool next(int i, Unit& u) const {
        const long L = (long)i * G + c; if (L >= nwg) return false;
        int wgid = (int)L; { const int q = nwg / NXCD, r = nwg % NXCD, xcd = wgid % NXCD, off = wgid / NXCD; wgid = (xcd < r ? xcd * (q + 1) : r * (q + 1) + (xcd - r) * q) + off; }
        const int nig = WGM * nN, gid = wgid / nig, fm = gid * WGM, gsz = (nM - fm) < WGM ? (nM - fm) : WGM;
        u.pm = fm + ((wgid % nig) % gsz); u.pn = (wgid % nig) / gsz; u.e = 0; return true;
    }
    __device__ __forceinline__ const char* baseA(const Gemm& g, const Unit& u, size_t tstep) const { return (const char*)g.A + (size_t)u.pm * tstep; }
    __device__ __forceinline__ const char* baseB(const Gemm& g, const Unit& u, size_t tstep) const { return (const char*)g.Bt + (size_t)u.pn * tstep; }
    __device__ __forceinline__ void a_ready(const Unit&) const {}
    __device__ __forceinline__ void done(const Unit&) const {}
};

__device__ __forceinline__ unsigned cvt_pk_bf16(float lo, float hi) { unsigned r; asm volatile("v_cvt_pk_bf16_f32 %0, %1, %2" : "=v"(r) : "v"(lo), "v"(hi)); return r; }
typedef float f32x2 __attribute__((ext_vector_type(2)));
__device__ __forceinline__ f32x2 gelu_pk(f32x2 v) {
    const f32x2 av = __builtin_elementwise_abs(v), d = av * 0.2316418882f + 1.0f;
    f32x2 t; t.x = __builtin_amdgcn_rcpf(d.x); t.y = __builtin_amdgcn_rcpf(d.y);
    f32x2 q = t * 0.5307027145f + (-0.7265760135f); q = q * t + 0.7107068705f; q = q * t + (-0.142248368f); q = q * t + 0.127414796f; q = q * t;
    const f32x2 s = (v * v) * (-0.72134752044f);
    f32x2 e; e.x = __builtin_amdgcn_exp2f(s.x); e.y = __builtin_amdgcn_exp2f(s.y);
    const f32x2 m = v * (q * e), r = v - m;
    f32x2 o; o.x = v.x < 0.f ? m.x : r.x; o.y = v.y < 0.f ? m.y : r.y; return o;
}

template <int ACT  > struct EpiBf16 {
    static constexpr bool PERM = true, AFTER_DRAIN = false; static_assert(ACT == 0 || ACT == 1, "EpiBf16: ACT is 0 (none) or 1 (gelu_pk)");
    bf16_t* O; int ldc; const float* bias; int split_cols; size_t split_stride; float scale0;
    __device__ __forceinline__ void operator()(const f32x4 (&acc)[2][2][4][2], const Unit& u, int wr, int wc, int fr, int fq) const {
        const int row0 = u.pm * BM + wr * 64 + fr; int colt = u.pn * BM; bf16_t* base = O;
        float sc = 1.f; if (split_cols) { const int t = colt / split_cols; base += (size_t)t * split_stride; colt -= t * split_cols; if (t == 0) sc = scale0; }
        const int col0 = colt + wc * 32 + 8 * fq, bcol0 = u.pn * BM + wc * 32 + 8 * fq;
        f32x4 bv[2][2];
#pragma unroll
        for (int bj = 0; bj < 2; ++bj)
#pragma unroll
            for (int n = 0; n < 2; ++n) bv[bj][n] = bias ? *(const f32x4*)(bias + bcol0 + bj * HALF + 4 * n) : (f32x4){0.f, 0.f, 0.f, 0.f};
#pragma unroll
        for (int ai = 0; ai < 2; ++ai)
#pragma unroll
            for (int m = 0; m < 4; ++m) { bf16_t* rowp = base + (size_t)(row0 + ai * HALF + m * 16) * ldc + col0;
#pragma unroll
                for (int bj = 0; bj < 2; ++bj) { f32x4 v0 = acc[ai][bj][m][0] + bv[bj][0], v1 = acc[ai][bj][m][1] + bv[bj][1];
                    if (ACT == 1) { f32x2 a = gelu_pk((f32x2){v0[0], v0[1]}), b = gelu_pk((f32x2){v0[2], v0[3]}), c = gelu_pk((f32x2){v1[0], v1[1]}), d = gelu_pk((f32x2){v1[2], v1[3]});
                        v0 = (f32x4){a.x, a.y, b.x, b.y}; v1 = (f32x4){c.x, c.y, d.x, d.y}; }
                    v0 = v0 * sc; v1 = v1 * sc; u32x4 w; w.x = cvt_pk_bf16(v0[0], v0[1]); w.y = cvt_pk_bf16(v0[2], v0[3]); w.z = cvt_pk_bf16(v1[0], v1[1]); w.w = cvt_pk_bf16(v1[2], v1[3]);
                    *(u32x4*)(rowp + bj * HALF) = w; } }
    }
};

template <class Epi, class Sched, bool ALIGN_EPI = false, bool SP2 = false>
__device__ __forceinline__ void gemm_phase(PG8_LAS unsigned char* lds, const Gemm g, const Sched& S, const Epi& E) {
    const int tid = threadIdx.x, wid = __builtin_amdgcn_readfirstlane(tid >> 6), lane = tid & 63, wr = wid >> 2, wc = wid & 3, fr = lane & 15, fq = lane >> 4;
    const int K = g.K, nt = K / BK;
    unsigned voffA[2], voffB[2];
#pragma unroll
    for (int i = 0; i < 2; ++i) { int R, C; stage_rc(tid * 16 + i * 8192, R, C); const int Rb = Epi::PERM ? ((R & ~31) + perm32(R & 31)) : R;
        voffA[i] = (unsigned)(R * K + C) * 2u; voffB[i] = (unsigned)(Rb * K + C) * 2u; }
    const size_t kstep = (size_t)(BK * 2);
    const size_t hstep = (size_t)HALF * K * 2;
    const size_t tstep = 2 * hstep;
    const unsigned ldsw = (unsigned)wid * 1024u;
    const int aoff = lds_byte(wr * 64 + fr, fq * 8), boff = lds_byte(wc * 32 + fr, fq * 8);
#define PG8_SA(b, h) (((b) * 2 + (h)) * HTB)
#define PG8_SB(b, h) ((4 + (b) * 2 + (h)) * HTB)
#define PG8_STAGE(bufoff, gbase, voff) do { _Pragma("unroll") for (int _i = 0; _i < 2; ++_i) \
        __builtin_amdgcn_global_load_lds((const unsigned*)((const char*)(gbase) + (voff)[_i]), (PG8_LAS unsigned*)(lds + (bufoff) + ldsw + _i * 8192), 16, 0, 0); } while (0)
#define PG8_LDA(dst, b, h) do { _Pragma("unroll") for (int m = 0; m < 4; ++m) _Pragma("unroll") for (int k = 0; k < 2; ++k) dst[m][k] = *(const PG8_LAS bf16x8*)(lds + PG8_SA(b, h) + aoff + m * 2048 + k * 1024); } while (0)
#define PG8_LDB(dst, b, h) do { _Pragma("unroll") for (int n = 0; n < 2; ++n) _Pragma("unroll") for (int k = 0; k < 2; ++k) dst[n][k] = *(const PG8_LAS bf16x8*)(lds + PG8_SB(b, h) + boff + n * 2048 + k * 1024); } while (0)
#define PG8_MMA(ai, bj, At, Bt) do { __builtin_amdgcn_s_setprio(1); _Pragma("unroll") for (int m = 0; m < 4; ++m) _Pragma("unroll") for (int n = 0; n < 2; ++n) _Pragma("unroll") for (int k = 0; k < 2; ++k) \
        acc[ai][bj][m][n] = __builtin_amdgcn_mfma_f32_16x16x32_bf16(Bt[n][k], At[m][k], acc[ai][bj][m][n], 0, 0, 0); __builtin_amdgcn_s_setprio(0); } while (0)
#define PG8_WAIT_V(n) asm volatile("s_waitcnt vmcnt(" #n ")" ::: "memory")
#define PG8_WAIT_L(n) asm volatile("s_waitcnt lgkmcnt(" #n ")" ::: "memory")
#define PG8_BAR __builtin_amdgcn_s_barrier()
#define PG8_SCHED __builtin_amdgcn_sched_barrier(0)
    Unit cur, nxt; int ui = 0;
    if (!S.next(0, cur)) return;
    f32x4 acc[2][2][4][2];
#pragma unroll
    for (int a = 0; a < 2; ++a)
#pragma unroll
        for (int b = 0; b < 2; ++b)
#pragma unroll
            for (int m = 0; m < 4; ++m)
#pragma unroll
                for (int n = 0; n < 2; ++n) acc[a][b][m][n] = (f32x4){0.f, 0.f, 0.f, 0.f};
    bf16x8 At[4][2], B0[2][2], B1[2][2];
    const char* cA = S.baseA(g, cur, tstep); const char* cB = S.baseB(g, cur, tstep);
    S.a_ready(cur);
    if constexpr (SP2) {
        PG8_STAGE(PG8_SB(0, 0), cB, voffB); PG8_STAGE(PG8_SB(0, 1), cB + hstep, voffB); PG8_STAGE(PG8_SA(0, 0), cA, voffA); PG8_STAGE(PG8_SA(0, 1), cA + hstep, voffA);
        if (wr == 1) PG8_BAR;
        PG8_WAIT_V(2); PG8_BAR;
        PG8_STAGE(PG8_SB(1, 0), cB + kstep, voffB); PG8_STAGE(PG8_SA(1, 0), cA + kstep, voffA); PG8_STAGE(PG8_SB(1, 1), cB + hstep + kstep, voffB);
        PG8_WAIT_V(6); PG8_BAR;
    } else {
        PG8_STAGE(PG8_SB(0, 0), cB, voffB); PG8_STAGE(PG8_SA(0, 0), cA, voffA); PG8_STAGE(PG8_SB(0, 1), cB + hstep, voffB); PG8_STAGE(PG8_SA(0, 1), cA + hstep, voffA);
        if (wr == 1) PG8_BAR;
        PG8_WAIT_V(4); PG8_BAR;
        PG8_STAGE(PG8_SB(1, 0), cB + kstep, voffB); PG8_STAGE(PG8_SA(1, 0), cA + kstep, voffA); PG8_STAGE(PG8_SB(1, 1), cB + hstep + kstep, voffB);
        PG8_WAIT_V(6); PG8_BAR;
    }
    for (;;) {
        const bool has_next = S.next(ui + 1, nxt);
        const char* nA = has_next ? S.baseA(g, nxt, tstep) : cA; const char* nB = has_next ? S.baseB(g, nxt, tstep) : cB;
        for (int t = 0; t < nt; t += 2) {
            const bool last = (t == nt - 2);
            const char* a1 = cA + (size_t)(t + 1) * kstep;
            const char* a2 = last ? nA : cA + (size_t)(t + 2) * kstep; const char* b2 = last ? nB : cB + (size_t)(t + 2) * kstep;
            const char* a3 = a2 + kstep; const char* b3 = b2 + kstep;
            if (last && has_next) S.a_ready(nxt);
            if constexpr (SP2) {
            PG8_LDB(B0, 0, 0); PG8_LDB(B1, 0, 1); PG8_SCHED; PG8_LDA(At, 0, 0); PG8_STAGE(PG8_SA(1, 1), a1 + hstep, voffA);
            PG8_WAIT_V(8); PG8_WAIT_L(0); PG8_BAR; PG8_MMA(0, 0, At, B0); PG8_MMA(0, 1, At, B1); PG8_BAR; PG8_SCHED;
            PG8_LDA(At, 0, 1); PG8_STAGE(PG8_SB(0, 0), b2, voffB); PG8_STAGE(PG8_SB(0, 1), b2 + hstep, voffB); PG8_STAGE(PG8_SA(0, 0), a2, voffA);
            PG8_WAIT_V(8); PG8_WAIT_L(0); PG8_BAR; PG8_MMA(1, 0, At, B0); PG8_MMA(1, 1, At, B1); PG8_BAR; PG8_SCHED;
            PG8_LDB(B0, 1, 0); PG8_LDB(B1, 1, 1); PG8_SCHED; PG8_LDA(At, 1, 0); PG8_STAGE(PG8_SA(0, 1), a2 + hstep, voffA);
            PG8_WAIT_V(8); PG8_WAIT_L(0); PG8_BAR; PG8_MMA(0, 0, At, B0); PG8_MMA(0, 1, At, B1); PG8_BAR; PG8_SCHED;
            PG8_LDA(At, 1, 1); PG8_STAGE(PG8_SB(1, 0), b3, voffB); PG8_STAGE(PG8_SB(1, 1), b3 + hstep, voffB); PG8_STAGE(PG8_SA(1, 0), a3, voffA);
            PG8_WAIT_V(8); PG8_WAIT_L(0); PG8_BAR; PG8_MMA(1, 0, At, B0); PG8_MMA(1, 1, At, B1); PG8_BAR; PG8_SCHED;
            } else {
            PG8_LDB(B0, 0, 0); PG8_SCHED; PG8_LDA(At, 0, 0); PG8_STAGE(PG8_SA(1, 1), a1 + hstep, voffA);
            PG8_WAIT_L(8); PG8_BAR; PG8_WAIT_L(0); PG8_MMA(0, 0, At, B0); PG8_BAR; PG8_SCHED;
            PG8_LDB(B1, 0, 1); PG8_STAGE(PG8_SB(0, 0), b2, voffB);
            PG8_BAR; PG8_WAIT_L(0); PG8_MMA(0, 1, At, B1); PG8_BAR;
            PG8_LDA(At, 0, 1); PG8_STAGE(PG8_SA(0, 0), a2, voffA);
            PG8_BAR; PG8_WAIT_L(0); PG8_MMA(1, 0, At, B0); PG8_BAR; PG8_SCHED;
            PG8_STAGE(PG8_SB(0, 1), b2 + hstep, voffB);
            PG8_WAIT_V(6); PG8_BAR; PG8_MMA(1, 1, At, B1); PG8_BAR;
            PG8_LDB(B0, 1, 0); PG8_SCHED; PG8_LDA(At, 1, 0); PG8_STAGE(PG8_SA(0, 1), a2 + hstep, voffA);
            PG8_WAIT_L(8); PG8_BAR; PG8_WAIT_L(0); PG8_MMA(0, 0, At, B0); PG8_BAR; PG8_SCHED;
            PG8_LDB(B1, 1, 1); PG8_STAGE(PG8_SB(1, 0), b3, voffB);
            PG8_BAR; PG8_WAIT_L(0); PG8_MMA(0, 1, At, B1); PG8_BAR;
            PG8_LDA(At, 1, 1); PG8_STAGE(PG8_SA(1, 0), a3, voffA);
            PG8_BAR; PG8_WAIT_L(0); PG8_MMA(1, 0, At, B0); PG8_BAR; PG8_SCHED;
            PG8_STAGE(PG8_SB(1, 1), b3 + hstep, voffB);
            PG8_WAIT_V(6); PG8_BAR; PG8_MMA(1, 1, At, B1); PG8_BAR;
            }
        }
        if constexpr (ALIGN_EPI) { if (wr == 0) PG8_BAR; }
        if constexpr (!Epi::AFTER_DRAIN) { E(acc, cur, wr, wc, fr, fq); S.done(cur); }
        if (!has_next) break;
#pragma unroll
        for (int a = 0; a < 2; ++a)
#pragma unroll
            for (int b = 0; b < 2; ++b)
#pragma unroll
                for (int m = 0; m < 4; ++m)
#pragma unroll
                    for (int n = 0; n < 2; ++n) acc[a][b][m][n] = (f32x4){0.f, 0.f, 0.f, 0.f};
        cur = nxt; cA = nA; cB = nB; ++ui;
        if constexpr (ALIGN_EPI) { if (wr == 1) PG8_BAR; }
    }
    PG8_WAIT_V(0);
    if constexpr (!ALIGN_EPI) { if (wr == 0) PG8_BAR; }
    PG8_BAR;
    if constexpr (Epi::AFTER_DRAIN) { E.fused(acc, cur, wr, wc, fr, fq, lds, wid, lane); S.done(cur); }
#undef PG8_SA
#undef PG8_SB
#undef PG8_STAGE
#undef PG8_LDA
#undef PG8_LDB
#undef PG8_MMA
#undef PG8_WAIT_V
#undef PG8_WAIT_L
#undef PG8_BAR
#undef PG8_SCHED
}
}
#define XB_TMO      128
#define XB_XCNT(j)  (256  + 64 * (j))
#define XB_XSUB(j)  (1280 + 64 * (j))
#define XB_XGEN(j)  (2304 + 64 * (j))
#define XB_TOP      3328
#define XB_TOPGEN   3392
#define XCD_BAR_WORDS 3456
#define XB_SPIN_CAP (1u << 18)

__device__ __forceinline__ unsigned xb_ld(unsigned* p)              { return __hip_atomic_load(p, __ATOMIC_RELAXED, __HIP_MEMORY_SCOPE_AGENT); }
__device__ __forceinline__ unsigned xb_add(unsigned* p, unsigned v) { return __hip_atomic_fetch_add(p, v, __ATOMIC_RELAXED, __HIP_MEMORY_SCOPE_AGENT); }
__device__ __forceinline__ unsigned xb_xcc_id() { return (unsigned)__builtin_amdgcn_s_getreg((3 << 11) | 20) & 0xFu; }
#define XB_SPIN(cond, bar) do { unsigned _sp = 0; while (cond) { __builtin_amdgcn_s_sleep(1); \
    if ((++_sp & 255u) == 0u) { if (xb_ld(&(bar)[XB_TMO])) break; if (_sp > XB_SPIN_CAP) { atomicAdd(&(bar)[XB_TMO], 1u); break; } } } } while (0)

struct XcdBarrier {
    unsigned* bar; unsigned x;
    volatile LAS unsigned* st;
};

__device__ __forceinline__ XcdBarrier xcd_barrier_post(unsigned* bar, volatile LAS unsigned* st) {
    XcdBarrier b; b.bar = bar; b.x = xb_xcc_id(); b.st = st;
    if (threadIdx.x == 0) (void)xb_add(&bar[XB_XCNT(b.x)], 1u);
    return b;
}
__device__ __forceinline__ void xcd_barrier_complete(unsigned* bar, unsigned x, unsigned& nloc, unsigned& nx) {
    const unsigned G = gridDim.x * gridDim.y * gridDim.z;
    unsigned sum, cnt, mine, sp = 0u;
    for (;;) {
        sum = 0u; cnt = 0u; mine = 0u;
#pragma unroll
        for (unsigned j = 0; j < 16; ++j) { const unsigned c = xb_ld(&bar[XB_XCNT(j)]); sum += c; cnt += (c > 0u) ? 1u : 0u; mine = (j == x) ? c : mine; }
        if (sum == G) break;
        __builtin_amdgcn_s_sleep(1);
        if ((++sp & 255u) == 0u) { if (xb_ld(&bar[XB_TMO])) break; if (sp > XB_SPIN_CAP) { atomicAdd(&bar[XB_TMO], 1u); break; } }
    }
    nloc = mine > 0u ? mine : 1u; nx = cnt > 0u ? cnt : 1u;
}

__device__ __forceinline__ void xcd_barrier(const XcdBarrier& b) {
    asm volatile("s_waitcnt vmcnt(0)" ::: "memory");
    __syncthreads();
    if (threadIdx.x == 0) {
        unsigned* bar = b.bar;
        __builtin_amdgcn_s_waitcnt(0);
        unsigned nloc = b.st[0], nx = b.st[1];
        if (nloc == 0u) { xcd_barrier_complete(bar, b.x, nloc, nx); b.st[0] = nloc; b.st[1] = nx; }
        const unsigned old = xb_add(&bar[XB_XSUB(b.x)], 1u);
        const unsigned gen = old / nloc;
        if (old + 1u == (gen + 1u) * nloc) {
            __builtin_amdgcn_fence(__ATOMIC_RELEASE, "agent");
            asm volatile("s_waitcnt vmcnt(0)" ::: "memory");
            const unsigned og = xb_add(&bar[XB_TOP], 1u);
            const unsigned tg = og / nx;
            if (og + 1u == (tg + 1u) * nx) xb_add(&bar[XB_TOPGEN], 1u);
            else XB_SPIN(xb_ld(&bar[XB_TOPGEN]) == tg, bar);
            __builtin_amdgcn_fence(__ATOMIC_ACQUIRE, "agent");
            xb_add(&bar[XB_XGEN(b.x)], 1u);
            asm volatile("s_waitcnt vmcnt(0)" ::: "memory");
        } else {
            XB_SPIN(xb_ld(&bar[XB_XGEN(b.x)]) == gen, bar);
            __builtin_amdgcn_fence(__ATOMIC_ACQUIRE, "agent");
            asm volatile("s_waitcnt vmcnt(0)" ::: "memory");
        }
    }
    __syncthreads();
}

typedef LAS unsigned char* ldsp;
typedef unsigned short bf16_t;
typedef short bf16x8 __attribute__((ext_vector_type(8)));
typedef short s16x4 __attribute__((ext_vector_type(4)));
typedef float f32x4 __attribute__((ext_vector_type(4)));
typedef float f32x16 __attribute__((ext_vector_type(16)));
typedef unsigned u32x4 __attribute__((ext_vector_type(4)));
typedef unsigned u32x2 __attribute__((ext_vector_type(2)));
typedef float f32x2_t __attribute__((ext_vector_type(2)));
typedef __bf16 bf16x2_t __attribute__((ext_vector_type(2)));

constexpr int NB = 2, SEQ = 8192, M = NB * SEQ, D = 1024;
constexpr int NIN = 8208, NMAIN = 7168, NEXP = 32;
constexpr int PT_MAX = 288;
constexpr float RMS_EPS = 1e-5f;
constexpr float QK_SCALE = 0.08838834764831845f;
constexpr float C2 = QK_SCALE * 1.4426950408889634f;

constexpr size_t MiB = 1u << 20;
constexpr size_t WS_CTL = 0, CTL_ZERO_BYTES = 1 * MiB;
constexpr size_t WS_MODP = 1 * MiB;
constexpr size_t WS_MOD = 1 * MiB + 832 * 1024;
constexpr size_t WS_ROPE = 2 * MiB;
constexpr size_t WS_KM = 3 * MiB;
constexpr size_t WS_COEF = 3 * MiB + 512 * 1024;
constexpr size_t WS_DG = 3 * MiB + 640 * 1024;
constexpr size_t WS_ROUTE = 4 * MiB;
constexpr size_t WS_GLOW = 5 * MiB;
constexpr size_t WS_WIN = 8 * MiB, WS_WV = 22 * MiB, WS_WOA = 24 * MiB, WS_WOB = 26 * MiB, WS_WOUT = 28 * MiB;
constexpr size_t WS_WE1 = 32 * MiB, WS_WE2 = 160 * MiB, WS_H = 224 * MiB;
constexpr size_t WS_MQ = 256 * MiB, WS_MK = 288 * MiB, WS_VT = 320 * MiB, WS_GQ = 352 * MiB, WS_GK = 368 * MiB, WS_GV = 384 * MiB, WS_GR = 416 * MiB, WS_GA = 448 * MiB, WS_GB = 480 * MiB;
constexpr size_t WS_OA = 512 * MiB, WS_OB = 544 * MiB, WS_TG = 576 * MiB, WS_GS = 608 * MiB, WS_T1 = 640 * MiB, WS_MERGED = 704 * MiB, WS_X1 = 736 * MiB;
constexpr size_t WS_XP = 256 * MiB, WS_ACT = 400 * MiB, WS_YS = 544 * MiB, WS_END = 800 * MiB;
constexpr int CW_BAR = 4096, CW_CNT = 16384;

constexpr int LDS_BYTES = 147456, LDSCTL_OFF = 145408;
constexpr int MISC_OFF = LDSCTL_OFF;
constexpr int TEXP_OFF = LDSCTL_OFF + 128;
constexpr int ESTART_OFF = TEXP_OFF + 288 * 4;
constexpr int LH_OFF = ESTART_OFF + 40 * 4;
constexpr int LBASE_OFF = LH_OFF + 128;
constexpr int ALIST_OFF = LBASE_OFF + 128;
static_assert(ALIST_OFF + 160 <= LDS_BYTES, "LDS ctl map");

struct Params {
    const float *x, *c, *w_ada, *b_ada, *norm1_w, *w_in, *gla_gate_w, *gla_gate_b, *gla_norm_w, *w_o_moba, *w_o_gla, *b_merge, *w_out, *norm2_w, *w_router, *b_router, *w_exp_in, *b_exp_in, *w_exp_out, *b_exp_out, *final_norm_w;
    float* out; unsigned char* ws;
};

__device__ __forceinline__ unsigned cvtpk(float lo, float hi) { f32x2_t v = {lo, hi}; bf16x2_t b = __builtin_convertvector(v, bf16x2_t); return __builtin_bit_cast(unsigned, b); }
__device__ __forceinline__ unsigned f2bf(float f) { return cvtpk(f, 0.f) & 0xffffu; }
__device__ __forceinline__ float bf2f(unsigned b) { return __uint_as_float(b << 16); }
__device__ __forceinline__ float bflo(unsigned w) { return __uint_as_float(w << 16); }
__device__ __forceinline__ float bfhi(unsigned w) { return __uint_as_float(w & 0xffff0000u); }
__device__ __forceinline__ int crow(int reg, int h) { return (reg & 3) + 8 * (reg >> 2) + 4 * h; }
__device__ __forceinline__ float wave_sum(float v) {
#pragma unroll
    for (int o = 1; o < 64; o <<= 1) v += __shfl_xor(v, o);
    return v;
}
__device__ __forceinline__ float sigmoidf_(float z) { return 1.0f / (1.0f + __expf(-z)); }
#define MFMA32(a, b, c) __builtin_amdgcn_mfma_f32_32x32x16_bf16((a), (b), (c), 0, 0, 0)
template <int S> __device__ __forceinline__ bf16x8 pack8(const f32x16& x) {
    u32x4 p; p.x = cvtpk(x[8 * S + 0], x[8 * S + 1]); p.y = cvtpk(x[8 * S + 2], x[8 * S + 3]); p.z = cvtpk(x[8 * S + 4], x[8 * S + 5]); p.w = cvtpk(x[8 * S + 6], x[8 * S + 7]);
    return __builtin_bit_cast(bf16x8, p);
}
__device__ __forceinline__ bf16x8 cat44(s16x4 lo, s16x4 hi) { return __builtin_shufflevector(lo, hi, 0, 1, 2, 3, 4, 5, 6, 7); }

namespace pg8 {
struct EpiInProj {
    static constexpr bool PERM = true, AFTER_DRAIN = false;
    unsigned char* ws; const float* b_merge;
    __device__ __forceinline__ void operator()(const f32x4 (&acc)[2][2][4][2], const Unit& u, int wr, int wc, int fr, int fq) const {
        const int pn = u.pn; const int row0 = u.pm * BM + wr * 64 + fr; const int cl0 = wc * 32 + 8 * fq;
        bf16_t* dst; int ld = 1024, colt; int mode;
        float osc = 1.f; const float* bias = nullptr;
        if (pn < 4) { dst = (bf16_t*)(ws + WS_MQ); colt = pn * 256; mode = 0; osc = C2; }
        else if (pn < 8) { dst = (bf16_t*)(ws + WS_MK); colt = (pn - 4) * 256; mode = 0; }
        else if (pn < 10) { dst = (bf16_t*)(ws + WS_GQ); ld = 512; colt = (pn - 8) * 256; mode = 1; osc = QK_SCALE; }
        else if (pn < 12) { dst = (bf16_t*)(ws + WS_GK); ld = 512; colt = (pn - 10) * 256; mode = 2; }
        else if (pn < 16) { dst = (bf16_t*)(ws + WS_GV); colt = (pn - 12) * 256; mode = 2; }
        else if (pn < 20) { dst = (bf16_t*)(ws + WS_GR); colt = (pn - 16) * 256; mode = 3; }
        else if (pn < 24) { dst = (bf16_t*)(ws + WS_GA); colt = (pn - 20) * 256; mode = 4; bias = b_merge; }
        else { dst = (bf16_t*)(ws + WS_GB); colt = (pn - 24) * 256; mode = 4; bias = b_merge + 1024; }
        const float* rc = (const float*)(ws + WS_ROPE); const float* rs = rc + SEQ * 16;
        f32x4 bv[2][2];
#pragma unroll
        for (int bj = 0; bj < 2; ++bj)
#pragma unroll
            for (int n = 0; n < 2; ++n) bv[bj][n] = (mode == 4) ? *(const f32x4*)(bias + colt + bj * HALF + cl0 + 4 * n) : (f32x4){0.f, 0.f, 0.f, 0.f};
#pragma unroll
        for (int ai = 0; ai < 2; ++ai)
#pragma unroll
            for (int m = 0; m < 4; ++m) {
                const int row = row0 + ai * HALF + m * 16;
                f32x4 cs0 = {1.f, 1.f, 1.f, 1.f}, cs1 = cs0, sn0 = {0.f, 0.f, 0.f, 0.f}, sn1 = sn0;
                const bool rope = (mode == 0) && (wc == 0);
                if (rope) { const int pos = row & (SEQ - 1); const float* pc = rc + pos * 16 + 8 * (fq & 1); const float* ps = rs + pos * 16 + 8 * (fq & 1);
                    cs0 = *(const f32x4*)pc; cs1 = *(const f32x4*)(pc + 4); sn0 = *(const f32x4*)ps; sn1 = *(const f32x4*)(ps + 4);
                    if (fq < 2) { sn0 = -sn0; sn1 = -sn1; } }
                bf16_t* rowp = dst + (size_t)row * ld + colt + cl0;
#pragma unroll
                for (int bj = 0; bj < 2; ++bj) {
                    f32x4 v0 = acc[ai][bj][m][0], v1 = acc[ai][bj][m][1];
                    if (rope) {
                        f32x4 p0, p1;
#pragma unroll
                        for (int i = 0; i < 4; ++i) { p0[i] = __shfl_xor(v0[i], 32); p1[i] = __shfl_xor(v1[i], 32); }
                        v0 = v0 * cs0 + p0 * sn0; v1 = v1 * cs1 + p1 * sn1;
                    }
                    if (mode <= 1) { v0 = v0 * osc; v1 = v1 * osc; }
                    if (mode == 3) {
#pragma unroll
                        for (int i = 0; i < 4; ++i) { v0[i] = v0[i] * sigmoidf_(v0[i]); v1[i] = v1[i] * sigmoidf_(v1[i]); } }
                    if (mode == 4) { v0 = v0 + bv[bj][0]; v1 = v1 + bv[bj][1];
#pragma unroll
                        for (int i = 0; i < 4; ++i) { v0[i] = sigmoidf_(v0[i]); v1[i] = sigmoidf_(v1[i]); } }
                    u32x4 w; w.x = cvtpk(v0[0], v0[1]); w.y = cvtpk(v0[2], v0[3]); w.z = cvtpk(v1[0], v1[1]); w.w = cvtpk(v1[2], v1[3]);
                    *(u32x4*)(rowp + bj * HALF) = w;
                }
            }
    }
};
struct EpiT1 {
    static constexpr bool PERM = true, AFTER_DRAIN = false;
    const bf16_t* GA; float* T1;
    __device__ __forceinline__ void operator()(const f32x4 (&acc)[2][2][4][2], const Unit& u, int wr, int wc, int fr, int fq) const {
        const int row0 = u.pm * BM + wr * 64 + fr, col0 = u.pn * BM + wc * 32 + 8 * fq;
#pragma unroll
        for (int ai = 0; ai < 2; ++ai)
#pragma unroll
            for (int m = 0; m < 4; ++m) { const size_t off = (size_t)(row0 + ai * HALF + m * 16) * 1024 + col0;
#pragma unroll
                for (int bj = 0; bj < 2; ++bj) { const u32x4 g = *(const u32x4*)(GA + off + bj * HALF);
                    f32x4 v0 = acc[ai][bj][m][0], v1 = acc[ai][bj][m][1];
                    v0[0] *= bflo(g.x); v0[1] *= bfhi(g.x); v0[2] *= bflo(g.y); v0[3] *= bfhi(g.y); v1[0] *= bflo(g.z); v1[1] *= bfhi(g.z); v1[2] *= bflo(g.w); v1[3] *= bfhi(g.w);
                    *(f32x4*)(T1 + off + bj * HALF) = v0; *(f32x4*)(T1 + off + bj * HALF + 4) = v1; } }
    }
};
struct EpiMerge {
    static constexpr bool PERM = true, AFTER_DRAIN = false;
    const bf16_t* GB; const float* T1; bf16_t* O;
    __device__ __forceinline__ void operator()(const f32x4 (&acc)[2][2][4][2], const Unit& u, int wr, int wc, int fr, int fq) const {
        const int row0 = u.pm * BM + wr * 64 + fr, col0 = u.pn * BM + wc * 32 + 8 * fq;
#pragma unroll
        for (int ai = 0; ai < 2; ++ai)
#pragma unroll
            for (int m = 0; m < 4; ++m) { const size_t off = (size_t)(row0 + ai * HALF + m * 16) * 1024 + col0;
#pragma unroll
                for (int bj = 0; bj < 2; ++bj) { const u32x4 g = *(const u32x4*)(GB + off + bj * HALF);
                    const f32x4 t0 = *(const f32x4*)(T1 + off + bj * HALF), t1 = *(const f32x4*)(T1 + off + bj * HALF + 4);
                    f32x4 v0 = acc[ai][bj][m][0], v1 = acc[ai][bj][m][1];
                    v0[0] = t0[0] + v0[0] * bflo(g.x); v0[1] = t0[1] + v0[1] * bfhi(g.x); v0[2] = t0[2] + v0[2] * bflo(g.y); v0[3] = t0[3] + v0[3] * bfhi(g.y);
                    v1[0] = t1[0] + v1[0] * bflo(g.z); v1[1] = t1[1] + v1[1] * bfhi(g.z); v1[2] = t1[2] + v1[2] * bflo(g.w); v1[3] = t1[3] + v1[3] * bfhi(g.w);
                    u32x4 w; w.x = cvtpk(v0[0], v0[1]); w.y = cvtpk(v0[2], v0[3]); w.z = cvtpk(v1[0], v1[1]); w.w = cvtpk(v1[2], v1[3]);
                    *(u32x4*)(O + off + bj * HALF) = w; } }
    }
};
struct EpiX1 {
    static constexpr bool PERM = false, AFTER_DRAIN = false;
    const float* x; const float* mod; float* X1;
    __device__ __forceinline__ void operator()(const f32x4 (&acc)[2][2][4][2], const Unit& u, int wr, int wc, int fr, int fq) const {
        const int row0 = u.pm * BM + wr * 64 + fr, col0 = u.pn * BM + wc * 32 + 4 * fq;
        const float* g1 = mod + ((u.pm * BM) >> 13) * 6144 + 2048;
        f32x4 gv[2][2];
#pragma unroll
        for (int bj = 0; bj < 2; ++bj)
#pragma unroll
            for (int n = 0; n < 2; ++n) gv[bj][n] = *(const f32x4*)(g1 + col0 + bj * HALF + n * 16);
#pragma unroll
        for (int ai = 0; ai < 2; ++ai)
#pragma unroll
            for (int m = 0; m < 4; ++m) { const size_t off = (size_t)(row0 + ai * HALF + m * 16) * 1024 + col0;
#pragma unroll
                for (int bj = 0; bj < 2; ++bj)
#pragma unroll
                    for (int n = 0; n < 2; ++n) { const f32x4 xv = *(const f32x4*)(x + off + bj * HALF + n * 16);
                        *(f32x4*)(X1 + off + bj * HALF + n * 16) = xv + gv[bj][n] * acc[ai][bj][m][n]; } }
    }
};
struct EpiMoE1 {
    static constexpr bool PERM = true, AFTER_DRAIN = false;
    const float* b1; bf16_t* ACT;
    __device__ __forceinline__ void operator()(const f32x4 (&acc)[2][2][4][2], const Unit& u, int wr, int wc, int fr, int fq) const {
        const int row0 = u.pm * BM + wr * 64 + fr, col0 = u.pn * BM + wc * 32 + 8 * fq;
        const float* bp = b1 + (size_t)u.e * 2048 + col0;
        f32x4 bv[2][2];
#pragma unroll
        for (int bj = 0; bj < 2; ++bj)
#pragma unroll
            for (int n = 0; n < 2; ++n) bv[bj][n] = *(const f32x4*)(bp + bj * HALF + 4 * n);
#pragma unroll
        for (int ai = 0; ai < 2; ++ai)
#pragma unroll
            for (int m = 0; m < 4; ++m) { bf16_t* rowp = ACT + (size_t)(row0 + ai * HALF + m * 16) * 1024 + (col0 >> 1);
#pragma unroll
                for (int bj = 0; bj < 2; ++bj) { const f32x4 v0 = acc[ai][bj][m][0] + bv[bj][0], v1 = acc[ai][bj][m][1] + bv[bj][1];
                    float o[4];
#pragma unroll
                    for (int q = 0; q < 4; ++q) { const float gl = q < 2 ? v0[2 * q] : v1[2 * q - 4], ln = q < 2 ? v0[2 * q + 1] : v1[2 * q - 3];
                        const float xg = fminf(gl, 7.0f), xl = fminf(fmaxf(ln, -7.0f), 7.0f); o[q] = xg * sigmoidf_(1.702f * xg) * (xl + 1.0f); }
                    u32x2 w; w.x = cvtpk(o[0], o[1]); w.y = cvtpk(o[2], o[3]);
                    *(u32x2*)(rowp + bj * 64) = w; } }
    }
};
struct EpiMoE2 {
    static constexpr bool PERM = true, AFTER_DRAIN = false;
    const float* b2; bf16_t* YS;
    __device__ __forceinline__ void operator()(const f32x4 (&acc)[2][2][4][2], const Unit& u, int wr, int wc, int fr, int fq) const {
        const int row0 = u.pm * BM + wr * 64 + fr, col0 = u.pn * BM + wc * 32 + 8 * fq;
        const float* bp = b2 + (size_t)u.e * 1024 + col0;
        f32x4 bv[2][2];
#pragma unroll
        for (int bj = 0; bj < 2; ++bj)
#pragma unroll
            for (int n = 0; n < 2; ++n) bv[bj][n] = *(const f32x4*)(bp + bj * HALF + 4 * n);
#pragma unroll
        for (int ai = 0; ai < 2; ++ai)
#pragma unroll
            for (int m = 0; m < 4; ++m) { bf16_t* rowp = YS + (size_t)(row0 + ai * HALF + m * 16) * 1024 + col0;
#pragma unroll
                for (int bj = 0; bj < 2; ++bj) { const f32x4 v0 = acc[ai][bj][m][0] + bv[bj][0], v1 = acc[ai][bj][m][1] + bv[bj][1];
                    u32x4 w; w.x = cvtpk(v0[0], v0[1]); w.y = cvtpk(v0[2], v0[3]); w.z = cvtpk(v1[0], v1[1]); w.w = cvtpk(v1[2], v1[3]);
                    *(u32x4*)(rowp + bj * HALF) = w; } }
    }
};
struct GroupedOrder {
    int nN, G, c; const LAS int* texp; const LAS int* estart; size_t ebytes;
    __device__ __forceinline__ bool next(int i, Unit& u) const {
        const int ntiles = estart[32] >> 8; const long L = (long)i * G + c; if (L >= (long)ntiles * nN) return false;
        u.pm = (int)(L / nN); u.pn = (int)(L % nN); u.e = texp[u.pm]; return true;
    }
    __device__ __forceinline__ const char* baseA(const Gemm& g, const Unit& u, size_t tstep) const { return (const char*)g.A + (size_t)u.pm * tstep; }
    __device__ __forceinline__ const char* baseB(const Gemm& g, const Unit& u, size_t tstep) const { return (const char*)g.Bt + (size_t)u.e * ebytes + (size_t)u.pn * tstep; }
    __device__ __forceinline__ void a_ready(const Unit&) const {}
    __device__ __forceinline__ void done(const Unit&) const {}
};
}

__device__ __forceinline__ void transpose_item64(const float* W, int ldw, bf16_t* WT, int K, int nblk, LAS float* scr, int item, int lane) {
    const int kb = item / nblk, nb = item % nblk, k0 = 64 * kb, n0 = 64 * nb;
    const float* src = W + (size_t)(k0 + (lane >> 4)) * ldw + n0 + 4 * (lane & 15);
    f32x4 v[16];
#pragma unroll
    for (int i = 0; i < 16; ++i) v[i] = *(const f32x4*)(src + (size_t)(4 * i) * ldw);
#pragma unroll
    for (int i = 0; i < 16; ++i) { LAS float* d = scr + ((lane >> 4) + 4 * i) * 65 + 4 * (lane & 15); d[0] = v[i][0]; d[1] = v[i][1]; d[2] = v[i][2]; d[3] = v[i][3]; }
    asm volatile("s_waitcnt lgkmcnt(0)" ::: "memory");
    const int c = lane & 7;
#pragma unroll
    for (int j = 0; j < 8; ++j) { const int n = (lane >> 3) + 8 * j; const LAS float* s = scr + (8 * c) * 65 + n;
        u32x4 o; o.x = cvtpk(s[0 * 65], s[1 * 65]); o.y = cvtpk(s[2 * 65], s[3 * 65]); o.z = cvtpk(s[4 * 65], s[5 * 65]); o.w = cvtpk(s[6 * 65], s[7 * 65]);
        *(u32x4*)(WT + (size_t)(n0 + n) * K + k0 + 8 * c) = o; }
    asm volatile("s_waitcnt lgkmcnt(0)" ::: "memory");
}
__device__ __forceinline__ void p0_prologue(const Params& P, ldsp lds, int tid, int lane, int wave, int bid, int G) {
    unsigned char* ws = P.ws;
    LAS float* scr = (LAS float*)(lds + wave * 16640);
    const int gw = bid * 8 + wave, NGW = G * 8;
    constexpr int I_S0 = 16 * 32, I_S1 = 16 * 48, I_S2 = 16 * 32, I_S3 = 16 * 16, I_SQ = 16 * 16, I_E1 = 16 * 32, I_E2 = 16 * 16;
    constexpr int NITEMS = I_S0 + I_S1 + I_S2 + I_S3 + 3 * I_SQ + 32 * I_E1 + 32 * I_E2;
    for (int it = gw; it < NITEMS; it += NGW) {
        int r = it;
        if (r < I_S0) { transpose_item64(P.w_in, NIN, (bf16_t*)(ws + WS_WIN), 1024, 32, scr, r, lane); continue; } r -= I_S0;
        if (r < I_S1) { transpose_item64(P.w_in + 3072, NIN, (bf16_t*)(ws + WS_WIN) + (size_t)2048 * 1024, 1024, 48, scr, r, lane); continue; } r -= I_S1;
        if (r < I_S2) { transpose_item64(P.w_in + 6160, NIN, (bf16_t*)(ws + WS_WIN) + (size_t)5120 * 1024, 1024, 32, scr, r, lane); continue; } r -= I_S2;
        if (r < I_S3) { transpose_item64(P.w_in + 2048, NIN, (bf16_t*)(ws + WS_WV), 1024, 16, scr, r, lane); continue; } r -= I_S3;
        if (r < I_SQ) { transpose_item64(P.w_o_moba, 1024, (bf16_t*)(ws + WS_WOA), 1024, 16, scr, r, lane); continue; } r -= I_SQ;
        if (r < I_SQ) { transpose_item64(P.w_o_gla, 1024, (bf16_t*)(ws + WS_WOB), 1024, 16, scr, r, lane); continue; } r -= I_SQ;
        if (r < I_SQ) { transpose_item64(P.w_out, 1024, (bf16_t*)(ws + WS_WOUT), 1024, 16, scr, r, lane); continue; } r -= I_SQ;
        if (r < 32 * I_E1) { const int e = r / I_E1; transpose_item64(P.w_exp_in + (size_t)e * 1024 * 2048, 2048, (bf16_t*)(ws + WS_WE1) + (size_t)e * 2048 * 1024, 1024, 32, scr, r % I_E1, lane); continue; } r -= 32 * I_E1;
        { const int e = r / I_E2; transpose_item64(P.w_exp_out + (size_t)e * 1024 * 1024, 1024, (bf16_t*)(ws + WS_WE2) + (size_t)e * 1024 * 1024, 1024, 16, scr, r % I_E2, lane); }
    }
    float* MODP = (float*)(ws + WS_MODP);
    for (int it = gw; it < 96 * 16; it += NGW) {
        const int g = it % 96, kc = it / 96, col = 64 * g + lane;
        const float c0 = P.c[64 * kc + lane], c1 = P.c[1024 + 64 * kc + lane];
        const float s0 = c0 * sigmoidf_(c0), s1 = c1 * sigmoidf_(c1);
        const float* wp = P.w_ada + (size_t)(64 * kc) * 6144 + col;
        float a0 = 0.f, a1 = 0.f;
#pragma unroll 16
        for (int kk = 0; kk < 64; ++kk) { const float w = wp[(size_t)kk * 6144]; a0 += __shfl(s0, kk) * w; a1 += __shfl(s1, kk) * w; }
        MODP[(kc * 2 + 0) * 6144 + col] = a0; MODP[(kc * 2 + 1) * 6144 + col] = a1;
    }
    { const int g = bid * 512 + tid;
      if (g < SEQ * 16) { const int pos = g >> 4, j = g & 15; const float inv = powf(500000.0f, -(float)j * (1.0f / 16.0f)); const float ang = (float)pos * inv;
          float* rc = (float*)(ws + WS_ROPE); rc[g] = cosf(ang); rc[SEQ * 16 + g] = sinf(ang); } }
}

__device__ __forceinline__ void p1_norm1(const Params& P, ldsp lds, int tid, int lane, int wave, int bid, int G) {
    unsigned char* ws = P.ws;
    const float* MODP = (const float*)(ws + WS_MODP);
    LAS float* A1 = (LAS float*)lds;
    LAS float* B1 = A1 + 2048;
    LAS float* WL = B1 + 2048;
    for (int idx = tid; idx < 2048; idx += 512) { const int b = idx >> 10, c = idx & 1023;
        float sh = P.b_ada[c], sc = P.b_ada[1024 + c];
#pragma unroll
        for (int kc = 0; kc < 16; ++kc) { sh += MODP[(kc * 2 + b) * 6144 + c]; sc += MODP[(kc * 2 + b) * 6144 + 1024 + c]; }
        A1[idx] = P.norm1_w[c] * (1.0f + sc); B1[idx] = sh; }
    for (int idx = tid; idx < 16384; idx += 512) { const int k = idx >> 4, t = idx & 15; WL[t * 1024 + k] = P.w_in[(size_t)k * NIN + 6144 + t]; }
    { const int g = bid * 512 + tid;
      if (g < 2 * 6144) { const int b = g / 6144, n = g % 6144; float s = P.b_ada[n];
#pragma unroll
          for (int kc = 0; kc < 16; ++kc) s += MODP[(kc * 2 + b) * 6144 + n];
          ((float*)(ws + WS_MOD))[g] = s; }
      else if (g < 2 * 6144 + 2048) { const int q = g - 2 * 6144, b = q >> 10, c = q & 1023; float sh = P.b_ada[3072 + c], sc = P.b_ada[4096 + c];
#pragma unroll
          for (int kc = 0; kc < 16; ++kc) { sh += MODP[(kc * 2 + b) * 6144 + 3072 + c]; sc += MODP[(kc * 2 + b) * 6144 + 4096 + c]; }
          float* CO = (float*)(ws + WS_COEF); CO[(b * 2 + 0) * 1024 + c] = P.norm2_w[c] * (1.0f + sc); CO[(b * 2 + 1) * 1024 + c] = sh; } }
    __syncthreads();
    const int gw = bid * 8 + wave, NGW = G * 8;
    bf16_t* H = (bf16_t*)(ws + WS_H); float* GLOW = (float*)(ws + WS_GLOW);
    for (int m = gw; m < M; m += NGW) {
        const int b = m >> 13;
        const f32x4* xr = (const f32x4*)(P.x + (size_t)m * 1024) + lane;
        f32x4 v[4]; float ss = 0.f;
#pragma unroll
        for (int j = 0; j < 4; ++j) { v[j] = xr[64 * j]; ss += (v[j][0] * v[j][0] + v[j][1] * v[j][1]) + (v[j][2] * v[j][2] + v[j][3] * v[j][3]); }
        const float rstd = 1.0f / sqrtf(wave_sum(ss) * (1.0f / 1024.0f) + RMS_EPS);
#pragma unroll
        for (int j = 0; j < 4; ++j) { const f32x4 a = *(const LAS f32x4*)(A1 + b * 1024 + 4 * lane + 256 * j), bb = *(const LAS f32x4*)(B1 + b * 1024 + 4 * lane + 256 * j);
            v[j] = v[j] * rstd * a + bb;
            u32x2 w; w.x = cvtpk(v[j][0], v[j][1]); w.y = cvtpk(v[j][2], v[j][3]);
            *(u32x2*)(H + (size_t)m * 1024 + 4 * lane + 256 * j) = w; }
        float mine = 0.f;
#pragma unroll 2
        for (int t = 0; t < 16; ++t) { float a = 0.f;
#pragma unroll
            for (int j = 0; j < 4; ++j) { const f32x4 wv = *(const LAS f32x4*)(WL + t * 1024 + 4 * lane + 256 * j); a += (v[j][0] * wv[0] + v[j][1] * wv[1]) + (v[j][2] * wv[2] + v[j][3] * wv[3]); }
            const float s = wave_sum(a); if (lane == t) mine = s; }
        if (lane < 16) GLOW[(size_t)m * 16 + lane] = mine;
    }
}

__device__ __forceinline__ void kmean_item(const Params& P, ldsp lds, int item, int tid) {
    const int blk = item & 31, bh = item >> 5, b = bh >> 3, hd = bh & 7;
    const bf16_t* MK = (const bf16_t*)(P.ws + WS_MK);
    const int c = tid & 15, rg = tid >> 4;
    float a[8];
#pragma unroll
    for (int j = 0; j < 8; ++j) a[j] = 0.f;
    const bf16_t* src = MK + (size_t)(b * SEQ + blk * 256 + rg * 8) * 1024 + hd * 128 + c * 8;
#pragma unroll
    for (int i = 0; i < 8; ++i) { const u32x4 v = *(const u32x4*)(src + (size_t)i * 1024);
        a[0] += bflo(v.x); a[1] += bfhi(v.x); a[2] += bflo(v.y); a[3] += bfhi(v.y); a[4] += bflo(v.z); a[5] += bfhi(v.z); a[6] += bflo(v.w); a[7] += bfhi(v.w); }
    LAS float* part = (LAS float*)lds;
#pragma unroll
    for (int j = 0; j < 8; ++j) part[rg * 128 + c * 8 + j] = a[j];
    __syncthreads();
    if (tid < 128) { float s = 0.f;
#pragma unroll 8
        for (int g = 0; g < 32; ++g) s += part[g * 128 + tid];
        s *= (1.0f / 256.0f);
        const unsigned hi = f2bf(s); const unsigned lo = f2bf(s - bf2f(hi));
        bf16_t* KMH = (bf16_t*)(P.ws + WS_KM); KMH[item * 128 + tid] = (bf16_t)hi; KMH[16 * 32 * 128 + item * 128 + tid] = (bf16_t)lo; }
    __syncthreads();
}

constexpr int GL_Q = 0;
constexpr int GL_KR = 17408;
constexpr int GL_KT = 34816;
constexpr int GL_VT = 53248;
constexpr int GL_GLOW = 90112;
constexpr int GL_CS = 94208;
constexpr int GL_BL = 96256;
constexpr int GL_RS = 96768;
__device__ __forceinline__ void gla_prep(const Params& P, ldsp lds, int tok0, int hg, bool need_q, int tid) {
    const unsigned char* ws = P.ws;
    if (tid < 256) { const f32x4 v = *(const f32x4*)((const float*)(ws + WS_GLOW) + (size_t)tok0 * 16 + tid * 4); *(LAS f32x4*)(lds + GL_GLOW + tid * 16) = v; }
    __syncthreads();
    const int d = tid & 127, rq = tid >> 7;
    float gw[16];
#pragma unroll
    for (int t = 0; t < 16; ++t) gw[t] = P.gla_gate_w[t * 512 + 128 * hg + d];
    const float gb = P.gla_gate_b[128 * hg + d];
    float bl[16]; float run = 0.f;
    const LAS float* glw = (const LAS float*)(lds + GL_GLOW);
#pragma unroll
    for (int i = 0; i < 16; ++i) { const int row = 16 * rq + i; float z = gb;
#pragma unroll
        for (int t4 = 0; t4 < 4; ++t4) { const f32x4 gv = *(const LAS f32x4*)(glw + row * 16 + 4 * t4); z += gv[0] * gw[4 * t4] + gv[1] * gw[4 * t4 + 1] + gv[2] * gw[4 * t4 + 2] + gv[3] * gw[4 * t4 + 3]; }
        const float ls = fminf(z, 0.f) - log1pf(__expf(-fabsf(z)));
        run += ls * (1.0f / 16.0f); bl[i] = run; }
    LAS float* CS = (LAS float*)(lds + GL_CS);
    CS[rq * 128 + d] = run;
    __syncthreads();
    float pre = 0.f, tot = 0.f;
#pragma unroll
    for (int q = 0; q < 4; ++q) { const float c = CS[q * 128 + d]; tot += c; if (q < rq) pre += c; }
    if (rq == 0) ((LAS float*)(lds + GL_BL))[d] = tot;
    const bf16_t* GK = (const bf16_t*)(ws + WS_GK); const bf16_t* GQ = (const bf16_t*)(ws + WS_GQ);
    LAS bf16_t* KR = (LAS bf16_t*)(lds + GL_KR); LAS bf16_t* KT = (LAS bf16_t*)(lds + GL_KT); LAS bf16_t* QI = (LAS bf16_t*)(lds + GL_Q);
#pragma unroll
    for (int i = 0; i < 16; ++i) { const int row = 16 * rq + i; const float bi = pre + bl[i];
        const float kv = bf2f(GK[(size_t)(tok0 + row) * 512 + 128 * hg + d]) * __expf(tot - bi);
        const bf16_t kb = (bf16_t)f2bf(kv); KR[row * 136 + d] = kb; KT[d * 72 + row] = kb;
        if (need_q) { const float qv = bf2f(GQ[(size_t)(tok0 + row) * 512 + 128 * hg + d]) * __expf(bi - tot); QI[row * 136 + d] = (bf16_t)f2bf(qv); } }
    { const int dv = tid & 255, half = tid >> 8; const bf16_t* GV = (const bf16_t*)(ws + WS_GV) + (size_t)(tok0 + 32 * half) * 1024 + 256 * hg + dv;
      unsigned pk[16];
#pragma unroll
      for (int c2 = 0; c2 < 16; ++c2) { const unsigned lo = GV[(size_t)(2 * c2) * 1024], hi = GV[(size_t)(2 * c2 + 1) * 1024]; pk[c2] = lo | (hi << 16); }
#pragma unroll
      for (int q = 0; q < 4; ++q) { u32x4 w; w.x = pk[4 * q]; w.y = pk[4 * q + 1]; w.z = pk[4 * q + 2]; w.w = pk[4 * q + 3]; *(LAS u32x4*)(lds + GL_VT + dv * 144 + 64 * half + 16 * q) = w; } }
    __syncthreads();
}
template <bool PHASE_C>
__device__ __forceinline__ void gla_unit(const Params& P, ldsp lds, int bh8, int g, int tid_in, int lane_in, int wave) {
    unsigned char* ws = P.ws;
    const int b = bh8 >> 2, hg = bh8 & 3;
    int tid = tid_in, lane = lane_in; int r = lane & 31, h = lane >> 5;
    f32x16 S[4];
    float* GS = (float*)(ws + WS_GS) + (size_t)(bh8 * 32 + g) * 128 * 256;
#pragma unroll
    for (int dkb = 0; dkb < 4; ++dkb)
#pragma unroll
        for (int reg = 0; reg < 16; ++reg) S[dkb][reg] = PHASE_C ? GS[(size_t)(32 * dkb + crow(reg, h)) * 256 + 32 * wave + r] : 0.f;
    float bsum = 0.f;
    const LAS float* BL = (const LAS float*)(lds + GL_BL);
    for (int ch = 0; ch < 4; ++ch) {
        tid = tid_in; asm volatile("" : "+v"(tid)); lane = tid & 63; r = lane & 31; h = lane >> 5;
        const int tok0 = b * SEQ + (g * 4 + ch) * 64;
        gla_prep(P, lds, tok0, hg, PHASE_C, tid);
#pragma unroll
        for (int dkb = 0; dkb < 4; ++dkb)
#pragma unroll
            for (int reg = 0; reg < 16; ++reg) S[dkb][reg] *= __expf(BL[32 * dkb + crow(reg, h)]);
        if (tid < 128) bsum += BL[tid];
        __builtin_amdgcn_sched_barrier(0);
        if (PHASE_C) {
            f32x16 at00, at01, at11;
#pragma unroll
            for (int i = 0; i < 16; ++i) { at00[i] = 0.f; at01[i] = 0.f; at11[i] = 0.f; }
#pragma unroll
            for (int s = 0; s < 8; ++s) {
                const bf16x8 ka0 = *(const LAS bf16x8*)(lds + GL_KR + r * 272 + 32 * s + 16 * h), ka1 = *(const LAS bf16x8*)(lds + GL_KR + (32 + r) * 272 + 32 * s + 16 * h);
                const bf16x8 qb0 = *(const LAS bf16x8*)(lds + GL_Q + r * 272 + 32 * s + 16 * h), qb1 = *(const LAS bf16x8*)(lds + GL_Q + (32 + r) * 272 + 32 * s + 16 * h);
                at00 = MFMA32(ka0, qb0, at00); at01 = MFMA32(ka0, qb1, at01); at11 = MFMA32(ka1, qb1, at11);
                if (s & 1) __builtin_amdgcn_sched_barrier(0);
            }
#pragma unroll
            for (int reg = 0; reg < 16; ++reg) { if (crow(reg, h) > r) { at00[reg] = 0.f; at11[reg] = 0.f; } }
            f32x16 ot0, ot1;
#pragma unroll
            for (int i = 0; i < 16; ++i) { ot0[i] = 0.f; ot1[i] = 0.f; }
#pragma unroll
            for (int dkb = 0; dkb < 4; ++dkb) {
                const bf16x8 sa0 = pack8<0>(S[dkb]), sa1 = pack8<1>(S[dkb]);
#pragma unroll
                for (int s = 0; s < 2; ++s) {
                    const int co = (32 * dkb + 16 * s + 4 * h) * 2;
                    const bf16x8 q0 = cat44(*(const LAS s16x4*)(lds + GL_Q + r * 272 + co), *(const LAS s16x4*)(lds + GL_Q + r * 272 + co + 16));
                    const bf16x8 q1 = cat44(*(const LAS s16x4*)(lds + GL_Q + (32 + r) * 272 + co), *(const LAS s16x4*)(lds + GL_Q + (32 + r) * 272 + co + 16));
                    ot0 = MFMA32(s == 0 ? sa0 : sa1, q0, ot0); ot1 = MFMA32(s == 0 ? sa0 : sa1, q1, ot1);
                }
                __builtin_amdgcn_sched_barrier(0);
            }
            {
                const bf16x8 p00a = pack8<0>(at00), p00b = pack8<1>(at00), p01a = pack8<0>(at01), p01b = pack8<1>(at01), p11a = pack8<0>(at11), p11b = pack8<1>(at11);
                const int vrow = GL_VT + (32 * wave + r) * 144;
#pragma unroll
                for (int s = 0; s < 2; ++s) {
                    const int c0 = (16 * s + 4 * h) * 2, c1 = (32 + 16 * s + 4 * h) * 2;
                    const bf16x8 v0 = cat44(*(const LAS s16x4*)(lds + vrow + c0), *(const LAS s16x4*)(lds + vrow + c0 + 16));
                    const bf16x8 v1 = cat44(*(const LAS s16x4*)(lds + vrow + c1), *(const LAS s16x4*)(lds + vrow + c1 + 16));
                    ot0 = MFMA32(v0, s == 0 ? p00a : p00b, ot0);
                    ot1 = MFMA32(v0, s == 0 ? p01a : p01b, ot1);
                    ot1 = MFMA32(v1, s == 0 ? p11a : p11b, ot1);
                }
            }
            __builtin_amdgcn_sched_barrier(0);
            LAS float* RS = (LAS float*)(lds + GL_RS);
            float q0 = 0.f, q1 = 0.f;
#pragma unroll
            for (int i = 0; i < 16; ++i) { q0 += ot0[i] * ot0[i]; q1 += ot1[i] * ot1[i]; }
            q0 += __shfl_xor(q0, 32); q1 += __shfl_xor(q1, 32);
            if (h == 0) { RS[wave * 64 + r] = q0; RS[wave * 64 + 32 + r] = q1; }
            __syncthreads();
            float t0 = 0.f, t1 = 0.f;
#pragma unroll
            for (int w = 0; w < 8; ++w) { t0 += RS[w * 64 + r]; t1 += RS[w * 64 + 32 + r]; }
            const float rs0 = 1.0f / sqrtf(t0 * (1.0f / 256.0f) + RMS_EPS), rs1 = 1.0f / sqrtf(t1 * (1.0f / 256.0f) + RMS_EPS);
            const bf16_t* GR = (const bf16_t*)(ws + WS_GR); bf16_t* OB = (bf16_t*)(ws + WS_OB);
#pragma unroll
            for (int ib = 0; ib < 2; ++ib) {
                const size_t rowoff = (size_t)(tok0 + 32 * ib + r) * 1024 + 256 * hg + 32 * wave;
#pragma unroll
                for (int rq = 0; rq < 4; ++rq) { const int dvl = 8 * rq + 4 * h;
                    const u32x2 gr = *(const u32x2*)(GR + rowoff + dvl);
                    const f32x4 nw = *(const f32x4*)(P.gla_norm_w + 32 * wave + dvl);
                    const float rs = ib == 0 ? rs0 : rs1;
                    float o[4];
#pragma unroll
                    for (int i = 0; i < 4; ++i) o[i] = (ib == 0 ? ot0[4 * rq + i] : ot1[4 * rq + i]) * rs * nw[i];
                    o[0] *= bflo(gr.x); o[1] *= bfhi(gr.x); o[2] *= bflo(gr.y); o[3] *= bfhi(gr.y);
                    u32x2 w; w.x = cvtpk(o[0], o[1]); w.y = cvtpk(o[2], o[3]);
                    *(u32x2*)(OB + rowoff + dvl) = w; }
            }
        }
        __builtin_amdgcn_sched_barrier(0);
#pragma unroll
        for (int s = 0; s < 4; ++s) {
            const bf16x8 vb = *(const LAS bf16x8*)(lds + GL_VT + (32 * wave + r) * 144 + 32 * s + 16 * h);
#pragma unroll
            for (int dkb = 0; dkb < 4; ++dkb) { const bf16x8 ka = *(const LAS bf16x8*)(lds + GL_KT + (32 * dkb + r) * 144 + 32 * s + 16 * h); S[dkb] = MFMA32(ka, vb, S[dkb]); }
            __builtin_amdgcn_sched_barrier(0);
        }
        __syncthreads();
    }
    if (!PHASE_C) {
        float* TG = (float*)(ws + WS_TG) + (size_t)(bh8 * 32 + g) * 128 * 256;
#pragma unroll
        for (int dkb = 0; dkb < 4; ++dkb)
#pragma unroll
            for (int reg = 0; reg < 16; ++reg) TG[(size_t)(32 * dkb + crow(reg, h)) * 256 + 32 * wave + r] = S[dkb][reg];
        if (tid < 128) ((float*)(ws + WS_DG))[(bh8 * 32 + g) * 128 + tid] = __expf(bsum);
    }
}
__device__ __forceinline__ void gla_scan(const Params& P, int tid, int bid) {
    const float* TG = (const float*)(P.ws + WS_TG); const float* DG = (const float*)(P.ws + WS_DG); float* GS = (float*)(P.ws + WS_GS);
#pragma unroll
    for (int rep = 0; rep < 2; ++rep) {
        const int e = bid * 512 + tid + rep * 131072; const int bh8 = e >> 15, dk = (e >> 8) & 127, dv = e & 255;
        float G = 0.f;
        for (int g = 0; g < 32; ++g) { const size_t off = ((size_t)(bh8 * 32 + g) * 128 + dk) * 256 + dv;
            GS[off] = G; G = DG[(bh8 * 32 + g) * 128 + dk] * G + TG[off]; }
    }
}

constexpr int AT_K = 0;
constexpr int AT_V = 17408;
__device__ __forceinline__ void attn_unit(const Params& P, ldsp lds, int b, int hd, int blk, int tid_in, int lane_in, int wave) {
    unsigned char* ws = P.ws;
    int tid = tid_in; asm volatile("" : "+v"(tid)); int lane = tid & 63; int r = lane & 31, h = lane >> 5;
    const bf16_t* MQ = (const bf16_t*)(ws + WS_MQ); const bf16_t* MK = (const bf16_t*)(ws + WS_MK); const bf16_t* VT = (const bf16_t*)(ws + WS_VT);
    const int tokq = b * SEQ + 256 * blk + 32 * wave + r;
    bf16x8 qr[8];
#pragma unroll
    for (int s = 0; s < 8; ++s) qr[s] = *(const bf16x8*)(MQ + (size_t)tokq * 1024 + 128 * hd + 16 * s + 8 * h);
    unsigned sel = 0u;
    if (blk > 0) {
        const bf16_t* KMH = (const bf16_t*)(ws + WS_KM) + (size_t)((b * 8 + hd) * 32 + r) * 128; const bf16_t* KML = KMH + 16 * 32 * 128;
        f32x16 gt;
#pragma unroll
        for (int i = 0; i < 16; ++i) gt[i] = 0.f;
#pragma unroll
        for (int s = 0; s < 8; ++s) { const bf16x8 a = *(const bf16x8*)(KMH + 16 * s + 8 * h), a2 = *(const bf16x8*)(KML + 16 * s + 8 * h); gt = MFMA32(a, qr[s], gt); gt = MFMA32(a2, qr[s], gt); }
#pragma unroll
        for (int round = 0; round < 3; ++round) {
            float best = -INFINITY; int bn = 64;
#pragma unroll
            for (int reg = 0; reg < 16; ++reg) { const int n = crow(reg, h); const bool ok = (n < blk) && !((sel >> n) & 1u); if (ok && gt[reg] > best) { best = gt[reg]; bn = n; } }
            const float ob = __shfl_xor(best, 32); const int on = __shfl_xor(bn, 32);
            if (ob > best || (ob == best && on < bn)) { best = ob; bn = on; }
            if (bn < 64) sel |= 1u << bn;
        }
    }
    unsigned wsel = sel;
#pragma unroll
    for (int o = 1; o < 32; o <<= 1) wsel |= (unsigned)__shfl_xor((int)wsel, o);
    wsel = (unsigned)__builtin_amdgcn_readfirstlane((int)wsel);
    volatile LAS int* AL = (volatile LAS int*)(lds + ALIST_OFF);
    if (tid == 0) AL[37] = 0;
    __syncthreads();
    if (lane == 0 && wsel) (void)__hip_atomic_fetch_or((LAS unsigned*)(lds + ALIST_OFF) + 37, wsel, __ATOMIC_RELAXED, __HIP_MEMORY_SCOPE_WORKGROUP);
    __syncthreads();
    if (tid == 0) { unsigned mm = (unsigned)AL[37]; int cnt = 0; AL[cnt++] = blk; while (mm) { const int n = __builtin_ctz(mm); mm &= mm - 1; AL[cnt++] = n; } AL[36] = cnt; }
    __syncthreads();
    const int NT = 4 * __builtin_amdgcn_readfirstlane(AL[36]);
    const bf16_t* Kbase = MK + (size_t)(b * SEQ) * 1024 + 128 * hd;
    const bf16_t* Vbase = VT + (size_t)(128 * hd) * M + (size_t)b * SEQ;
    u32x4 kreg[2], vreg[2];
    int kp_row0 = tid >> 4, kp_ch = tid & 15;
    int vp_d0 = tid >> 3, vp_ch = tid & 7;
#define AT_LOAD(ti) do { const int nb_ = AL[(ti) >> 2]; const int key0_ = 256 * nb_ + 64 * ((ti) & 3); \
        kreg[0] = *(const u32x4*)(Kbase + (size_t)(key0_ + kp_row0) * 1024 + 8 * kp_ch); kreg[1] = *(const u32x4*)(Kbase + (size_t)(key0_ + 32 + kp_row0) * 1024 + 8 * kp_ch); \
        vreg[0] = *(const u32x4*)(Vbase + (size_t)vp_d0 * M + key0_ + 8 * vp_ch); vreg[1] = *(const u32x4*)(Vbase + (size_t)(64 + vp_d0) * M + key0_ + 8 * vp_ch); } while (0)
#define AT_STORE() do { *(LAS u32x4*)(lds + AT_K + kp_row0 * 272 + 16 * kp_ch) = kreg[0]; *(LAS u32x4*)(lds + AT_K + (32 + kp_row0) * 272 + 16 * kp_ch) = kreg[1]; \
        *(LAS u32x2*)(lds + AT_V + vp_d0 * 136 + 16 * vp_ch) = (u32x2){vreg[0].x, vreg[0].y}; *(LAS u32x2*)(lds + AT_V + vp_d0 * 136 + 16 * vp_ch + 8) = (u32x2){vreg[0].z, vreg[0].w}; \
        *(LAS u32x2*)(lds + AT_V + (64 + vp_d0) * 136 + 16 * vp_ch) = (u32x2){vreg[1].x, vreg[1].y}; *(LAS u32x2*)(lds + AT_V + (64 + vp_d0) * 136 + 16 * vp_ch + 8) = (u32x2){vreg[1].z, vreg[1].w}; } while (0)
    f32x16 o[4];
#pragma unroll
    for (int db = 0; db < 4; ++db)
#pragma unroll
        for (int i = 0; i < 16; ++i) o[db][i] = 0.f;
    float mrun = -1e30f, lrun = 0.f;
    AT_LOAD(0); AT_STORE();
    __syncthreads();
    for (int ti = 0; ti < NT; ++ti) {
        tid = tid_in; asm volatile("" : "+v"(tid)); lane = tid & 63; r = lane & 31; h = lane >> 5; kp_row0 = tid >> 4; kp_ch = tid & 15; vp_d0 = tid >> 3; vp_ch = tid & 7;
        const int nb = __builtin_amdgcn_readfirstlane(AL[ti >> 2]); const int t = ti & 3; const bool own = ti < 4;
        const bool active = own ? (64 * t <= 32 * wave + 31) : (((wsel >> nb) & 1u) != 0u);
        if (active) {
            f32x16 p0, p1;
#pragma unroll
            for (int i = 0; i < 16; ++i) { p0[i] = 0.f; p1[i] = 0.f; }
#pragma unroll
            for (int s = 0; s < 8; ++s) {
                const bf16x8 ka = *(const LAS bf16x8*)(lds + AT_K + r * 272 + 32 * s + 16 * h), kb = *(const LAS bf16x8*)(lds + AT_K + (32 + r) * 272 + 32 * s + 16 * h);
                p0 = MFMA32(ka, qr[s], p0); p1 = MFMA32(kb, qr[s], p1);
                if (s & 1) __builtin_amdgcn_sched_barrier(0);
            }
            if (own) { const int ql = 32 * wave + r;
#pragma unroll
                for (int reg = 0; reg < 16; ++reg) { const int kl = 64 * t + crow(reg, h); if (kl > ql) p0[reg] = -INFINITY; if (kl + 32 > ql) p1[reg] = -INFINITY; } }
            else if (!((sel >> nb) & 1u)) {
#pragma unroll
                for (int reg = 0; reg < 16; ++reg) { p0[reg] = -INFINITY; p1[reg] = -INFINITY; } }
            float tm = fmaxf(p0[0], p1[0]);
#pragma unroll
            for (int reg = 1; reg < 16; ++reg) tm = fmaxf(tm, fmaxf(p0[reg], p1[reg]));
            tm = fmaxf(tm, __shfl_xor(tm, 32));
            const float mnew = fmaxf(mrun, tm);
            const float f = __builtin_amdgcn_exp2f(mrun - mnew);
            mrun = mnew;
            float ps = 0.f;
#pragma unroll
            for (int reg = 0; reg < 16; ++reg) { p0[reg] = __builtin_amdgcn_exp2f(p0[reg] - mnew); p1[reg] = __builtin_amdgcn_exp2f(p1[reg] - mnew); ps += p0[reg] + p1[reg]; }
            lrun = lrun * f + ps;
            if (!__all(f == 1.0f)) {
#pragma unroll
                for (int db = 0; db < 4; ++db)
#pragma unroll
                    for (int i = 0; i < 16; ++i) o[db][i] *= f; }
            const bf16x8 pf0 = pack8<0>(p0), pf1 = pack8<1>(p0), pf2 = pack8<0>(p1), pf3 = pack8<1>(p1);
            __builtin_amdgcn_sched_barrier(0);
            if (ti + 1 < NT) AT_LOAD(ti + 1);
            __builtin_amdgcn_sched_barrier(0);
#pragma unroll
            for (int db = 0; db < 4; ++db) {
                const int vrow = AT_V + (32 * db + r) * 136;
#pragma unroll
                for (int ks = 0; ks < 4; ++ks) {
                    const int c0 = (16 * ks + 4 * h) * 2;
                    const bf16x8 vf = cat44(*(const LAS s16x4*)(lds + vrow + c0), *(const LAS s16x4*)(lds + vrow + c0 + 16));
                    o[db] = MFMA32(vf, ks == 0 ? pf0 : ks == 1 ? pf1 : ks == 2 ? pf2 : pf3, o[db]);
                }
                __builtin_amdgcn_sched_barrier(0);
            }
        } else if (ti + 1 < NT) AT_LOAD(ti + 1);
        __syncthreads();
        if (ti + 1 < NT) AT_STORE();
        __syncthreads();
    }
#undef AT_LOAD
#undef AT_STORE
    lrun += __shfl_xor(lrun, 32);
    const float inv = 1.0f / lrun;
    bf16_t* OA = (bf16_t*)(ws + WS_OA) + (size_t)tokq * 1024 + 128 * hd;
#pragma unroll
    for (int db = 0; db < 4; ++db)
#pragma unroll
        for (int rq = 0; rq < 4; ++rq) { u32x2 w; w.x = cvtpk(o[db][4 * rq] * inv, o[db][4 * rq + 1] * inv); w.y = cvtpk(o[db][4 * rq + 2] * inv, o[db][4 * rq + 3] * inv);
            *(u32x2*)(OA + 32 * db + 8 * rq + 4 * h) = w; }
}

__device__ __forceinline__ void p8_router(const Params& P, ldsp lds, int tid, int lane, int wave, int bid, int G) {
    unsigned char* ws = P.ws;
    LAS float* WR = (LAS float*)lds;
    for (int idx = tid; idx < 32768; idx += 512) { const int c = idx >> 5, e = idx & 31; WR[e * 1024 + c] = P.w_router[idx]; }
    LAS int* LH = (LAS int*)(lds + LH_OFF); LAS int* LBASE = (LAS int*)(lds + LBASE_OFF);
    if (tid < 32) LH[tid] = 0;
    __syncthreads();
    const float* X1 = (const float*)(ws + WS_X1); const float* CO = (const float*)(ws + WS_COEF); bf16_t* H = (bf16_t*)(ws + WS_H);
    const int gw = bid * 8 + wave, NGW = G * 8;
    int rec_e = 0, rec_r = 0, rec_m = -1; float rec_w = 0.f;
    int it = 0;
    for (int m = gw; m < M; m += NGW, ++it) {
        const int b = m >> 13;
        const f32x4* xr = (const f32x4*)(X1 + (size_t)m * 1024) + lane;
        f32x4 v[4]; float ss = 0.f;
#pragma unroll
        for (int j = 0; j < 4; ++j) { v[j] = xr[64 * j]; ss += (v[j][0] * v[j][0] + v[j][1] * v[j][1]) + (v[j][2] * v[j][2] + v[j][3] * v[j][3]); }
        const float rstd = 1.0f / sqrtf(wave_sum(ss) * (1.0f / 1024.0f) + RMS_EPS);
#pragma unroll
        for (int j = 0; j < 4; ++j) { const f32x4 a = *(const f32x4*)(CO + (b * 2 + 0) * 1024 + 4 * lane + 256 * j), bb = *(const f32x4*)(CO + (b * 2 + 1) * 1024 + 4 * lane + 256 * j);
            v[j] = v[j] * rstd * a + bb;
            u32x2 w; w.x = cvtpk(v[j][0], v[j][1]); w.y = cvtpk(v[j][2], v[j][3]);
            *(u32x2*)(H + (size_t)m * 1024 + 4 * lane + 256 * j) = w; }
        float lg[32];
#pragma unroll
        for (int e = 0; e < 32; ++e) { float a = 0.f;
#pragma unroll
            for (int j = 0; j < 4; ++j) { const f32x4 wv = *(const LAS f32x4*)(WR + e * 1024 + 4 * lane + 256 * j); a += (v[j][0] * wv[0] + v[j][1] * wv[1]) + (v[j][2] * wv[2] + v[j][3] * wv[3]); }
            lg[e] = wave_sum(a) + P.b_router[e]; }
        unsigned used = 0u; int te[4]; float tl[4];
#pragma unroll
        for (int k = 0; k < 4; ++k) { float best = -INFINITY; int be = 0;
#pragma unroll
            for (int e = 0; e < 32; ++e) { const bool ok = !((used >> e) & 1u); if (ok && lg[e] > best) { best = lg[e]; be = e; } }
            used |= 1u << be; te[k] = be; tl[k] = best; }
        const float e1 = __expf(tl[1] - tl[0]), e2 = __expf(tl[2] - tl[0]), e3 = __expf(tl[3] - tl[0]); const float isum = 1.0f / (1.0f + e1 + e2 + e3);
        const float tw[4] = {isum, e1 * isum, e2 * isum, e3 * isum};
        if ((lane >> 2) == it) { const int k = lane & 3; rec_e = k == 0 ? te[0] : k == 1 ? te[1] : k == 2 ? te[2] : te[3]; rec_w = k == 0 ? tw[0] : k == 1 ? tw[1] : k == 2 ? tw[2] : tw[3]; rec_m = m;
            rec_r = __hip_atomic_fetch_add(LH + rec_e, 1, __ATOMIC_RELAXED, __HIP_MEMORY_SCOPE_WORKGROUP); }
    }
    __syncthreads();
    if (tid < 32) LBASE[tid] = (int)atomicAdd((unsigned*)(ws + WS_CTL) + CW_CNT + 64 * tid, (unsigned)LH[tid]);
    __syncthreads();
    if (rec_m >= 0) { const int k = lane & 3; int* TOPE = (int*)(ws + WS_ROUTE); float* TOPW = (float*)(ws + WS_ROUTE + 256 * 1024); int* RANK = (int*)(ws + WS_ROUTE + 512 * 1024);
        TOPE[rec_m * 4 + k] = rec_e; TOPW[rec_m * 4 + k] = rec_w; RANK[rec_m * 4 + k] = LBASE[rec_e] + rec_r; }
}

__device__ __forceinline__ void p9_layout(const Params& P, ldsp lds, int tid) {
    LAS int* TEXP = (LAS int*)(lds + TEXP_OFF); LAS int* EST = (LAS int*)(lds + ESTART_OFF);
    if (tid == 0) { int acc = 0; const unsigned* cnt = (const unsigned*)(P.ws + WS_CTL) + CW_CNT;
        for (int e = 0; e < 32; ++e) { const int c = (int)__hip_atomic_load(cnt + 64 * e, __ATOMIC_RELAXED, __HIP_MEMORY_SCOPE_AGENT); const int pad = (c + 255) & ~255; EST[e] = acc;
            for (int t = acc >> 8; t < (acc + pad) >> 8; ++t) TEXP[t] = e; acc += pad; }
        EST[32] = acc; }
    __syncthreads();
}
__device__ __forceinline__ void p9_gather(const Params& P, ldsp lds, int tid, int lane, int wave, int bid, int G) {
    unsigned char* ws = P.ws;
    const LAS int* EST = (const LAS int*)(lds + ESTART_OFF);
    const int* TOPE = (const int*)(ws + WS_ROUTE); const int* RANK = (const int*)(ws + WS_ROUTE + 512 * 1024); int* POS = (int*)(ws + WS_ROUTE + 768 * 1024);
    const bf16_t* H = (const bf16_t*)(ws + WS_H); bf16_t* XP = (bf16_t*)(ws + WS_XP);
    const int gw = bid * 8 + wave, NGW = G * 8;
    for (int m = gw; m < M; m += NGW) {
        int pos = 0;
        if (lane < 4) { pos = EST[TOPE[m * 4 + lane]] + RANK[m * 4 + lane]; POS[m * 4 + lane] = pos; }
        const u32x4 a = *(const u32x4*)(H + (size_t)m * 1024 + 16 * lane), bq = *(const u32x4*)(H + (size_t)m * 1024 + 16 * lane + 8);
#pragma unroll
        for (int k = 0; k < 4; ++k) { const int pk = __shfl(pos, k); bf16_t* dp = XP + (size_t)pk * 1024 + 16 * lane; *(u32x4*)dp = a; *(u32x4*)(dp + 8) = bq; }
    }
}

__device__ __forceinline__ void p12_final(const Params& P, int lane, int wave, int bid, int G) {
    unsigned char* ws = P.ws;
    const float* X1 = (const float*)(ws + WS_X1); const float* MOD = (const float*)(ws + WS_MOD); const bf16_t* YS = (const bf16_t*)(ws + WS_YS);
    const float* TOPW = (const float*)(ws + WS_ROUTE + 256 * 1024); const int* POS = (const int*)(ws + WS_ROUTE + 768 * 1024);
    const int gw = bid * 8 + wave, NGW = G * 8;
    for (int m = gw; m < M; m += NGW) {
        const int b = m >> 13;
        int pos = 0; float wt = 0.f;
        if (lane < 4) { pos = POS[m * 4 + lane]; wt = TOPW[m * 4 + lane]; }
        const f32x4* xr = (const f32x4*)(X1 + (size_t)m * 1024) + lane;
        f32x4 v[4], acc[4];
#pragma unroll
        for (int j = 0; j < 4; ++j) { v[j] = xr[64 * j]; acc[j] = (f32x4){0.f, 0.f, 0.f, 0.f}; }
#pragma unroll
        for (int k = 0; k < 4; ++k) { const int pk = __shfl(pos, k); const float wk = __shfl(wt, k);
#pragma unroll
            for (int j = 0; j < 4; ++j) { const u32x2 y = *(const u32x2*)(YS + (size_t)pk * 1024 + 4 * lane + 256 * j);
                acc[j][0] += wk * bflo(y.x); acc[j][1] += wk * bfhi(y.x); acc[j][2] += wk * bflo(y.y); acc[j][3] += wk * bfhi(y.y); } }
        float ss = 0.f;
#pragma unroll
        for (int j = 0; j < 4; ++j) { const f32x4 g2 = *(const f32x4*)(MOD + b * 6144 + 5120 + 4 * lane + 256 * j); v[j] = v[j] + g2 * acc[j];
            ss += (v[j][0] * v[j][0] + v[j][1] * v[j][1]) + (v[j][2] * v[j][2] + v[j][3] * v[j][3]); }
        const float rstd = 1.0f / sqrtf(wave_sum(ss) * (1.0f / 1024.0f) + RMS_EPS);
#pragma unroll
        for (int j = 0; j < 4; ++j) { const f32x4 fw = *(const f32x4*)(P.final_norm_w + 4 * lane + 256 * j); *((f32x4*)(P.out + (size_t)m * 1024) + lane + 64 * j) = v[j] * rstd * fw; }
    }
}

__global__ void __launch_bounds__(512, 2) mk_fwd(Params P) {
    extern __shared__ __attribute__((aligned(16))) unsigned char lds_raw[];
    ldsp lds = (ldsp)lds_raw;
    const int tid = threadIdx.x, lane = tid & 63, wave = __builtin_amdgcn_readfirstlane(tid >> 6);
    const int bid = blockIdx.x, G = gridDim.x;
    unsigned char* ws = P.ws;
    for (int u = tid; u < (LDS_BYTES - LDSCTL_OFF) / 4; u += 512) ((LAS unsigned*)(lds + LDSCTL_OFF))[u] = 0u;
    __syncthreads();
    volatile LAS unsigned* MISC = (volatile LAS unsigned*)(lds + MISC_OFF);
    XcdBarrier bar = xcd_barrier_post((unsigned*)(ws + WS_CTL) + CW_BAR, MISC + 8);

#if !defined(PHMASK) || ((PHMASK >> 0) & 1)
    p0_prologue(P, lds, tid, lane, wave, bid, G);
    xcd_barrier(bar);
#endif
#if !defined(PHMASK) || ((PHMASK >> 1) & 1)
    p1_norm1(P, lds, tid, lane, wave, bid, G);
    xcd_barrier(bar);
#endif
#if !defined(PHMASK) || ((PHMASK >> 2) & 1)
    {
        pg8::Gemm g{(const pg8::bf16_t*)(ws + WS_H), (const pg8::bf16_t*)(ws + WS_WIN), M, NMAIN, 1024}; pg8::StaticOrder S; S.init(M, NMAIN, G, bid);
        pg8::EpiInProj E{ws, P.b_merge};
        pg8::gemm_phase<pg8::EpiInProj, pg8::StaticOrder, true, true>(lds, g, S, E);
    }
    {
        pg8::Gemm g{(const pg8::bf16_t*)(ws + WS_WV), (const pg8::bf16_t*)(ws + WS_H), 1024, M, 1024}; pg8::StaticOrder S; S.init(1024, M, G, bid);
        pg8::EpiBf16<0> E{(pg8::bf16_t*)(ws + WS_VT), M, nullptr, 0, 0, 1.f};
        pg8::gemm_phase<pg8::EpiBf16<0>, pg8::StaticOrder, true, true>(lds, g, S, E);
    }
    xcd_barrier(bar);
#endif
#if !defined(PHMASK) || ((PHMASK >> 3) & 1)
    for (int item = bid; item < 512; item += G) kmean_item(P, lds, item, tid);
    for (int u = bid; u < 256; u += G) gla_unit<false>(P, lds, u >> 5, u & 31, tid, lane, wave);
    xcd_barrier(bar);
#endif
#if !defined(PHMASK) || ((PHMASK >> 4) & 1)
    if (bid * 512 + tid < 131072) gla_scan(P, tid, bid);
    xcd_barrier(bar);
#endif
#if !defined(PHMASK) || ((PHMASK >> 5) & 1)
#if !defined(PH5SUB) || (PH5SUB & 1)
    for (int u = bid; u < 256; u += G) gla_unit<true>(P, lds, u >> 5, u & 31, tid, lane, wave);
#endif
#if !defined(PH5SUB) || (PH5SUB & 2)
    for (int u = bid; u < 256; u += G) { const int bh = u >> 4, s = u & 15;
        attn_unit(P, lds, bh >> 3, bh & 7, 31 - s, tid, lane, wave);
        attn_unit(P, lds, bh >> 3, bh & 7, s, tid, lane, wave); }
#endif
    xcd_barrier(bar);
#endif
#if !defined(PHMASK) || ((PHMASK >> 6) & 1)
    {
        pg8::Gemm g{(const pg8::bf16_t*)(ws + WS_OA), (const pg8::bf16_t*)(ws + WS_WOA), M, 1024, 1024}; pg8::StaticOrder S; S.init(M, 1024, G, bid);
        pg8::EpiT1 E{(const bf16_t*)(ws + WS_GA), (float*)(ws + WS_T1)};
        pg8::gemm_phase<pg8::EpiT1, pg8::StaticOrder, true, true>(lds, g, S, E);
    }
    {
        pg8::Gemm g{(const pg8::bf16_t*)(ws + WS_OB), (const pg8::bf16_t*)(ws + WS_WOB), M, 1024, 1024}; pg8::StaticOrder S; S.init(M, 1024, G, bid);
        pg8::EpiMerge E{(const bf16_t*)(ws + WS_GB), (const float*)(ws + WS_T1), (bf16_t*)(ws + WS_MERGED)};
        pg8::gemm_phase<pg8::EpiMerge, pg8::StaticOrder, true, true>(lds, g, S, E);
    }
    xcd_barrier(bar);
#endif
#if !defined(PHMASK) || ((PHMASK >> 7) & 1)
    {
        pg8::Gemm g{(const pg8::bf16_t*)(ws + WS_MERGED), (const pg8::bf16_t*)(ws + WS_WOUT), M, 1024, 1024}; pg8::StaticOrder S; S.init(M, 1024, G, bid);
        pg8::EpiX1 E{P.x, (const float*)(ws + WS_MOD), (float*)(ws + WS_X1)};
        pg8::gemm_phase<pg8::EpiX1, pg8::StaticOrder, true, true>(lds, g, S, E);
    }
    xcd_barrier(bar);
#endif
#if !defined(PHMASK) || ((PHMASK >> 8) & 1)
    p8_router(P, lds, tid, lane, wave, bid, G);
    xcd_barrier(bar);
#endif
#if !defined(PHMASK) || ((PHMASK >> 9) & 1)
    p9_layout(P, lds, tid);
    p9_gather(P, lds, tid, lane, wave, bid, G);
    xcd_barrier(bar);
#endif
#if !defined(PHMASK) || ((PHMASK >> 10) & 1)
    {
        pg8::Gemm g{(const pg8::bf16_t*)(ws + WS_XP), (const pg8::bf16_t*)(ws + WS_WE1), PT_MAX * 256, 2048, 1024};
        pg8::GroupedOrder S{8, G, bid, (const LAS int*)(lds + TEXP_OFF), (const LAS int*)(lds + ESTART_OFF), (size_t)2048 * 1024 * 2};
        pg8::EpiMoE1 E{P.b_exp_in, (bf16_t*)(ws + WS_ACT)};
        pg8::gemm_phase<pg8::EpiMoE1, pg8::GroupedOrder, true, true>(lds, g, S, E);
    }
    xcd_barrier(bar);
#endif
#if !defined(PHMASK) || ((PHMASK >> 11) & 1)
    {
        pg8::Gemm g{(const pg8::bf16_t*)(ws + WS_ACT), (const pg8::bf16_t*)(ws + WS_WE2), PT_MAX * 256, 1024, 1024};
        pg8::GroupedOrder S{4, G, bid, (const LAS int*)(lds + TEXP_OFF), (const LAS int*)(lds + ESTART_OFF), (size_t)1024 * 1024 * 2};
        pg8::EpiMoE2 E{P.b_exp_out, (bf16_t*)(ws + WS_YS)};
        pg8::gemm_phase<pg8::EpiMoE2, pg8::GroupedOrder, true, true>(lds, g, S, E);
    }
    xcd_barrier(bar);
#endif
#if !defined(PHMASK) || ((PHMASK >> 12) & 1)
    p12_final(P, lane, wave, bid, G);
#endif
}

extern "C" void kernel_launch(void* const* d_in, const int* in_sizes, int n_in, void* d_out, int out_size, void* d_ws, size_t ws_size, hipStream_t stream) {
    static int grid = 0;
    if (grid == 0) {
        if (n_in != 21 || in_sizes[0] != M * D || out_size != M * D || ws_size < WS_END) { fprintf(stderr, "kernel_launch: unexpected shapes (n_in %d, in0 %d, out %d, ws %zu); nothing launched\n", n_in, n_in > 0 ? in_sizes[0] : -1, out_size, ws_size); grid = -1; return; }
        int dev = 0, cus = 0, per_cu = 0;
        if (hipGetDevice(&dev) != hipSuccess || hipDeviceGetAttribute(&cus, hipDeviceAttributeMultiprocessorCount, dev) != hipSuccess) { grid = -1; return; }
        if (hipFuncSetAttribute((const void*)mk_fwd, hipFuncAttributeMaxDynamicSharedMemorySize, LDS_BYTES) != hipSuccess) { fprintf(stderr, "kernel_launch: hipFuncSetAttribute failed\n"); grid = -1; return; }
        if (hipOccupancyMaxActiveBlocksPerMultiprocessor(&per_cu, (const void*)mk_fwd, 512, LDS_BYTES) != hipSuccess || per_cu < 1) { fprintf(stderr, "kernel_launch: occupancy query says %d workgroups per CU; nothing launched\n", per_cu); (void)hipGetLastError(); grid = -1; return; }
        grid = cus;
    }
    if (grid < 0) return;
    (void)hipMemsetAsync((char*)d_ws + WS_CTL, 0, CTL_ZERO_BYTES, stream);
    Params p{};
    const float** pp = (const float**)&p;
    for (int i = 0; i < 21; ++i) pp[i] = (const float*)d_in[i];
    p.out = (float*)d_out; p.ws = (unsigned char*)d_ws;
    void* args[] = {&p};
    hipError_t e = hipLaunchCooperativeKernel((const void*)mk_fwd, dim3(grid), dim3(512), args, LDS_BYTES, stream);
    if (e != hipSuccess) fprintf(stderr, "kernel_launch: cooperative launch failed: %s (grid %d)\n", hipGetErrorString(e), grid);
}
```

```cpp
#include <hip/hip_runtime.h>
#include <hip/hip_bf16.h>
#include <cstdio>
#include <cstdint>
#define LAS __attribute__((address_space(3)))
namespace pg8 {
#define PG8_LAS __attribute__((address_space(3)))
typedef unsigned short bf16_t;
typedef short bf16x8 __attribute__((ext_vector_type(8)));
typedef float f32x4 __attribute__((ext_vector_type(4)));
typedef unsigned u32x4 __attribute__((ext_vector_type(4)));
constexpr int BM = 256, BK = 64, HALF = 128, HTB = HALF * BK * 2  , STAGE_BYTES = 8 * HTB, NXCD = 8, WGM = 8;

__host__ __device__ __forceinline__ int lds_byte(int r, int c) { const int st = (r >> 4) * 2 + (c >> 5), rr = r & 15, cc = c & 31, ob = rr * 64 + cc * 2; return st * 1024 + (ob ^ (((ob >> 9) & 1) << 5)); }
__host__ __device__ __forceinline__ void stage_rc(int b, int& R, int& C) { const int st = b / 1024, sb = b % 1024, swz = sb ^ (((sb >> 9) & 1) << 5); R = (st >> 1) * 16 + swz / 64; C = (st & 1) * 32 + (swz % 64) / 2; }
__host__ __device__ __forceinline__ int perm32(int rho) { const int n = rho >> 4, i = rho & 15; return 8 * (i >> 2) + 4 * n + (i & 3); }

struct Unit { int pm, pn, e; };
struct Gemm { const bf16_t* A; const bf16_t* Bt; int M, N, K; };

struct StaticOrder {
    int nM, nN, nwg, G, c, rep;
    __host__ __device__ void init(int M, int N, int G_, int c_, int rep_ = 1) { nM = M / BM; nN = N / BM; nwg = nM * nN; G = G_; c = c_; rep = rep_; }
    __host__ __device__ bool next(int i, Unit& u) const {
        long L = (long)i * G + c; if (L >= (long)nwg * rep) return false; if (L >= nwg) L -= nwg;
        int wgid = (int)L; { const int q = nwg / NXCD, r = nwg % NXCD, xcd = wgid % NXCD, off = wgid / NXCD; wgid = (xcd < r ? xcd * (q + 1) : r * (q + 1) + (xcd - r) * q) + off; }
        const int nig = WGM * nN, gid = wgid / nig, fm = gid * WGM, gsz = (nM - fm) < WGM ? (nM - fm) : WGM;
        u.pm = fm + ((wgid % nig) % gsz); u.pn = (wgid % nig) / gsz; u.e = 0; return true;
    }
    __device__ __forceinline__ const char* baseA(const Gemm& g, const Unit& u, size_t tstep) const { return (const char*)g.A + (size_t)u.pm * tstep; }
    __device__ __forceinline__ const char* baseB(const Gemm& g, const Unit& u, size_t tstep) const { return (const char*)g.Bt + (size_t)u.pn * tstep; }
    __device__ __forceinline__ void a_ready(const Unit&) const {}
    __device__ __forceinline__ void done(const Unit&) const {}
};

__device__ __forceinline__ unsigned cvt_pk_bf16(float lo, float hi) { unsigned r; asm volatile("v_cvt_pk_bf16_f32 %0, %1, %2" : "=v"(r) : "v"(lo), "v"(hi)); return r; }
typedef float f32x2 __attribute__((ext_vector_type(2)));
__device__ __forceinline__ f32x2 gelu_pk(f32x2 v) {
    const f32x2 av = __builtin_elementwise_abs(v), d = av * 0.2316418882f + 1.0f;
    f32x2 t; t.x = __builtin_amdgcn_rcpf(d.x); t.y = __builtin_amdgcn_rcpf(d.y);
    f32x2 q = t * 0.5307027145f + (-0.7265760135f); q = q * t + 0.7107068705f; q = q * t + (-0.142248368f); q = q * t + 0.127414796f; q = q * t;
    const f32x2 s = (v * v) * (-0.72134752044f);
    f32x2 e; e.x = __builtin_amdgcn_exp2f(s.x); e.y = __builtin_amdgcn_exp2f(s.y);
    const f32x2 m = v * (q * e), r = v - m;
    f32x2 o; o.x = v.x < 0.f ? m.x : r.x; o.y = v.y < 0.f ? m.y : r.y; return o;
}

template <int ACT  > struct EpiBf16 {
    static constexpr bool PERM = true, AFTER_DRAIN = false; static_assert(ACT == 0 || ACT == 1, "EpiBf16: ACT is 0 (none) or 1 (gelu_pk)");
    bf16_t* O; int ldc; const float* bias; int split_cols; size_t split_stride; float scale0;
    __device__ __forceinline__ void operator()(const f32x4 (&acc)[2][2][4][2], const Unit& u, int wr, int wc, int fr, int fq) const {
        const int row0 = u.pm * BM + wr * 64 + fr; int colt = u.pn * BM; bf16_t* base = O;
        float sc = 1.f; if (split_cols) { const int t = colt / split_cols; base += (size_t)t * split_stride; colt -= t * split_cols; if (t == 0) sc = scale0; }
        const int col0 = colt + wc * 32 + 8 * fq, bcol0 = u.pn * BM + wc * 32 + 8 * fq;
        f32x4 bv[2][2];
#pragma unroll
        for (int bj = 0; bj < 2; ++bj)
#pragma unroll
            for (int n = 0; n < 2; ++n) bv[bj][n] = bias ? *(const f32x4*)(bias + bcol0 + bj * HALF + 4 * n) : (f32x4){0.f, 0.f, 0.f, 0.f};
#pragma unroll
        for (int ai = 0; ai < 2; ++ai)
#pragma unroll
            for (int m = 0; m < 4; ++m) { bf16_t* rowp = base + (size_t)(row0 + ai * HALF + m * 16) * ldc + col0;
#pragma unroll
                for (int bj = 0; bj < 2; ++bj) { f32x4 v0 = acc[ai][bj][m][0] + bv[bj][0], v1 = acc[ai][bj][m][1] + bv[bj][1];
                    if (ACT == 1) { f32x2 a = gelu_pk((f32x2){v0[0], v0[1]}), b = gelu_pk((f32x2){v0[2], v0[3]}), c = gelu_pk((f32x2){v1[0], v1[1]}), d = gelu_pk((f32x2){v1[2], v1[3]});
                        v0 = (f32x4){a.x, a.y, b.x, b.y}; v1 = (f32x4){c.x, c.y, d.x, d.y}; }
                    v0 = v0 * sc; v1 = v1 * sc; u32x4 w; w.x = cvt_pk_bf16(v0[0], v0[1]); w.y = cvt_pk_bf16(v0[2], v0[3]); w.z = cvt_pk_bf16(v1[0], v1[1]); w.w = cvt_pk_bf16(v1[2], v1[3]);
                    *(u32x4*)(rowp + bj * HALF) = w; } }
    }
};

template <class Epi, class Sched, bool ALIGN_EPI = false, bool SP2 = false>
__device__ __forceinline__ void gemm_phase(PG8_LAS unsigned char* lds, const Gemm g, const Sched& S, const Epi& E) {
    const int tid = threadIdx.x, wid = __builtin_amdgcn_readfirstlane(tid >> 6), lane = tid & 63, wr = wid >> 2, wc = wid & 3, fr = lane & 15, fq = lane >> 4;
    const int K = g.K, nt = K / BK;
    unsigned voffA[2], voffB[2];
#pragma unroll
    for (int i = 0; i < 2; ++i) { int R, C; stage_rc(tid * 16 + i * 8192, R, C); const int Rb = Epi::PERM ? ((R & ~31) + perm32(R & 31)) : R;
        voffA[i] = (unsigned)(R * K + C) * 2u; voffB[i] = (unsigned)(Rb * K + C) * 2u; }
    const size_t kstep = (size_t)(BK * 2);
    const size_t hstep = (size_t)HALF * K * 2;
    const size_t tstep = 2 * hstep;
    const unsigned ldsw = (unsigned)wid * 1024u;
    const int aoff = lds_byte(wr * 64 + fr, fq * 8), boff = lds_byte(wc * 32 + fr, fq * 8);
#define PG8_SA(b, h) (((b) * 2 + (h)) * HTB)
#define PG8_SB(b, h) ((4 + (b) * 2 + (h)) * HTB)
#define PG8_STAGE(bufoff, gbase, voff) do { _Pragma("unroll") for (int _i = 0; _i < 2; ++_i) \
        __builtin_amdgcn_global_load_lds((const unsigned*)((const char*)(gbase) + (voff)[_i]), (PG8_LAS unsigned*)(lds + (bufoff) + ldsw + _i * 8192), 16, 0, 0); } while (0)
#define PG8_LDA(dst, b, h) do { _Pragma("unroll") for (int m = 0; m < 4; ++m) _Pragma("unroll") for (int k = 0; k < 2; ++k) dst[m][k] = *(const PG8_LAS bf16x8*)(lds + PG8_SA(b, h) + aoff + m * 2048 + k * 1024); } while (0)
#define PG8_LDB(dst, b, h) do { _Pragma("unroll") for (int n = 0; n < 2; ++n) _Pragma("unroll") for (int k = 0; k < 2; ++k) dst[n][k] = *(const PG8_LAS bf16x8*)(lds + PG8_SB(b, h) + boff + n * 2048 + k * 1024); } while (0)
#define PG8_MMA(ai, bj, At, Bt) do { __builtin_amdgcn_s_setprio(1); _Pragma("unroll") for (int m = 0; m < 4; ++m) _Pragma("unroll") for (int n = 0; n < 2; ++n) _Pragma("unroll") for (int k = 0; k < 2; ++k) \
        acc[ai][bj][m][n] = __builtin_amdgcn_mfma_f32_16x16x32_bf16(Bt[n][k], At[m][k], acc[ai][bj][m][n], 0, 0, 0); __builtin_amdgcn_s_setprio(0); } while (0)
#define PG8_WAIT_V(n) asm volatile("s_waitcnt vmcnt(" #n ")" ::: "memory")
#define PG8_WAIT_L(n) asm volatile("s_waitcnt lgkmcnt(" #n ")" ::: "memory")
#define PG8_BAR __builtin_amdgcn_s_barrier()
#define PG8_SCHED __builtin_amdgcn_sched_barrier(0)
    Unit cur, nxt; int ui = 0;
    if (!S.next(0, cur)) return;
    f32x4 acc[2][2][4][2];
#pragma unroll
    for (int a = 0; a < 2; ++a)
#pragma unroll
        for (int b = 0; b < 2; ++b)
#pragma unroll
            for (int m = 0; m < 4; ++m)
#pragma unroll
                for (int n = 0; n < 2; ++n) acc[a][b][m][n] = (f32x4){0.f, 0.f, 0.f, 0.f};
    bf16x8 At[4][2], B0[2][2], B1[2][2];
    const char* cA = S.baseA(g, cur, tstep); const char* cB = S.baseB(g, cur, tstep);
    S.a_ready(cur);
    if constexpr (SP2) {
        PG8_STAGE(PG8_SB(0, 0), cB, voffB); PG8_STAGE(PG8_SB(0, 1), cB + hstep, voffB); PG8_STAGE(PG8_SA(0, 0), cA, voffA); PG8_STAGE(PG8_SA(0, 1), cA + hstep, voffA);
        if (wr == 1) PG8_BAR;
        PG8_WAIT_V(2); PG8_BAR;
        PG8_STAGE(PG8_SB(1, 0), cB + kstep, voffB); PG8_STAGE(PG8_SA(1, 0), cA + kstep, voffA); PG8_STAGE(PG8_SB(1, 1), cB + hstep + kstep, voffB);
        PG8_WAIT_V(6); PG8_BAR;
    } else {
        PG8_STAGE(PG8_SB(0, 0), cB, voffB); PG8_STAGE(PG8_SA(0, 0), cA, voffA); PG8_STAGE(PG8_SB(0, 1), cB + hstep, voffB); PG8_STAGE(PG8_SA(0, 1), cA + hstep, voffA);
        if (wr == 1) PG8_BAR;
        PG8_WAIT_V(4); PG8_BAR;
        PG8_STAGE(PG8_SB(1, 0), cB + kstep, voffB); PG8_STAGE(PG8_SA(1, 0), cA + kstep, voffA); PG8_STAGE(PG8_SB(1, 1), cB + hstep + kstep, voffB);
        PG8_WAIT_V(6); PG8_BAR;
    }
    for (;;) {
        const bool has_next = S.next(ui + 1, nxt);
        const char* nA = has_next ? S.baseA(g, nxt, tstep) : cA; const char* nB = has_next ? S.baseB(g, nxt, tstep) : cB;
        for (int t = 0; t < nt; t += 2) {
            const bool last = (t == nt - 2);
            const char* a1 = cA + (size_t)(t + 1) * kstep;
            const char* a2 = last ? nA : cA + (size_t)(t + 2) * kstep; const char* b2 = last ? nB : cB + (size_t)(t + 2) * kstep;
            const char* a3 = a2 + kstep; const char* b3 = b2 + kstep;
            if (last && has_next) S.a_ready(nxt);
            if constexpr (SP2) {
            PG8_LDB(B0, 0, 0); PG8_LDB(B1, 0, 1); PG8_SCHED; PG8_LDA(At, 0, 0); PG8_STAGE(PG8_SA(1, 1), a1 + hstep, voffA);
            PG8_WAIT_V(8); PG8_WAIT_L(0); PG8_BAR; PG8_MMA(0, 0, At, B0); PG8_MMA(0, 1, At, B1); PG8_BAR; PG8_SCHED;
            PG8_LDA(At, 0, 1); PG8_STAGE(PG8_SB(0, 0), b2, voffB); PG8_STAGE(PG8_SB(0, 1), b2 + hstep, voffB); PG8_STAGE(PG8_SA(0, 0), a2, voffA);
            PG8_WAIT_V(8); PG8_WAIT_L(0); PG8_BAR; PG8_MMA(1, 0, At, B0); PG8_MMA(1, 1, At, B1); PG8_BAR; PG8_SCHED;
            PG8_LDB(B0, 1, 0); PG8_LDB(B1, 1, 1); PG8_SCHED; PG8_LDA(At, 1, 0); PG8_STAGE(PG8_SA(0, 1), a2 + hstep, voffA);
            PG8_WAIT_V(8); PG8_WAIT_L(0); PG8_BAR; PG8_MMA(0, 0, At, B0); PG8_MMA(0, 1, At, B1); PG8_BAR; PG8_SCHED;
            PG8_LDA(At, 1, 1); PG8_STAGE(PG8_SB(1, 0), b3, voffB); PG8_STAGE(PG8_SB(1, 1), b3 + hstep, voffB); PG8_STAGE(PG8_SA(1, 0), a3, voffA);
            PG8_WAIT_V(8); PG8_WAIT_L(0); PG8_BAR; PG8_MMA(1, 0, At, B0); PG8_MMA(1, 1, At, B1); PG8_BAR; PG8_SCHED;
            } else {
            PG8_LDB(B0, 0, 0); PG8_SCHED; PG8_LDA(At, 0, 0); PG8_STAGE(PG8_SA(1, 1), a1 + hstep, voffA);
            PG8_WAIT_L(8); PG8_BAR; PG8_WAIT_L(0); PG8_MMA(0, 0, At, B0); PG8_BAR; PG8_SCHED;
            PG8_LDB(B1, 0, 1); PG8_STAGE(PG8_SB(0, 0), b2, voffB);
            PG8_BAR; PG8_WAIT_L(0); PG8_MMA(0, 1, At, B1); PG8_BAR;
            PG8_LDA(At, 0, 1); PG8_STAGE(PG8_SA(0, 0), a2, voffA);
            PG8_BAR; PG8_WAIT_L(0); PG8_MMA(1, 0, At, B0); PG8_BAR; PG8_SCHED;
            PG8_STAGE(PG8_SB(0, 1), b2 + hstep, voffB);
            PG8_WAIT_V(6); PG8_BAR; PG8_MMA(1, 1, At, B1); PG8_BAR;
            PG8_LDB(B0, 1, 0); PG8_SCHED; PG8_LDA(At, 1, 0); PG8_STAGE(PG8_SA(0, 1), a2 + hstep, voffA);
            PG8_WAIT_L(8); PG8_BAR; PG8_WAIT_L(0); PG8_MMA(0, 0, At, B0); PG8_BAR; PG8_SCHED;
            PG8_LDB(B1, 1, 1); PG8_STAGE(PG8_SB(1, 0), b3, voffB);
            PG8_BAR; PG8_WAIT_L(0); PG8_MMA(0, 1, At, B1); PG8_BAR;
            PG8_LDA(At, 1, 1); PG8_STAGE(PG8_SA(1, 0), a3, voffA);
            PG8_BAR; PG8_WAIT_L(0); PG8_MMA(1, 0, At, B0); PG8_BAR; PG8_SCHED;
            PG8_STAGE(PG8_SB(1, 1), b3 + hstep, voffB);
            PG8_WAIT_V(6); PG8_BAR; PG8_MMA(1, 1, At, B1); PG8_BAR;
            }
        }
        if constexpr (ALIGN_EPI) { if (wr == 0) PG8_BAR; }
        if constexpr (!Epi::AFTER_DRAIN) { E(acc, cur, wr, wc, fr, fq); S.done(cur); }
        if (!has_next) break;
#pragma unroll
        for (int a = 0; a < 2; ++a)
#pragma unroll
            for (int b = 0; b < 2; ++b)
#pragma unroll
                for (int m = 0; m < 4; ++m)
#pragma unroll
                    for (int n = 0; n < 2; ++n) acc[a][b][m][n] = (f32x4){0.f, 0.f, 0.f, 0.f};
        cur = nxt; cA = nA; cB = nB; ++ui;
        if constexpr (ALIGN_EPI) { if (wr == 1) PG8_BAR; }
    }
    PG8_WAIT_V(0);
    if constexpr (!ALIGN_EPI) { if (wr == 0) PG8_BAR; }
    PG8_BAR;
    if constexpr (Epi::AFTER_DRAIN) { E.fused(acc, cur, wr, wc, fr, fq, lds, wid, lane); S.done(cur); }
#undef PG8_SA
#undef PG8_SB
#undef PG8_STAGE
#undef PG8_LDA
#undef PG8_LDB
#undef PG8_MMA
#undef PG8_WAIT_V
#undef PG8_WAIT_L
#undef PG8_BAR
#undef PG8_SCHED
}
}
#define XB_TMO      128
#define XB_XCNT(j)  (256  + 64 * (j))
#define XB_XSUB(j)  (1280 + 64 * (j))
#define XB_XGEN(j)  (2304 + 64 * (j))
#define XB_TOP      3328
#define XB_TOPGEN   3392
#define XCD_BAR_WORDS 3456
#define XB_SPIN_CAP (1u << 18)

__device__ __forceinline__ unsigned xb_ld(unsigned* p)              { return __hip_atomic_load(p, __ATOMIC_RELAXED, __HIP_MEMORY_SCOPE_AGENT); }
__device__ __forceinline__ unsigned xb_add(unsigned* p, unsigned v) { return __hip_atomic_fetch_add(p, v, __ATOMIC_RELAXED, __HIP_MEMORY_SCOPE_AGENT); }
__device__ __forceinline__ unsigned xb_xcc_id() { return (unsigned)__builtin_amdgcn_s_getreg((3 << 11) | 20) & 0xFu; }
#define XB_SPIN(cond, bar) do { unsigned _sp = 0; while (cond) { __builtin_amdgcn_s_sleep(1); \
    if ((++_sp & 255u) == 0u) { if (xb_ld(&(bar)[XB_TMO])) break; if (_sp > XB_SPIN_CAP) { atomicAdd(&(bar)[XB_TMO], 1u); break; } } } } while (0)

struct XcdBarrier {
    unsigned* bar; unsigned x;
    volatile LAS unsigned* st;
};

__device__ __forceinline__ XcdBarrier xcd_barrier_post(unsigned* bar, volatile LAS unsigned* st) {
    XcdBarrier b; b.bar = bar; b.x = xb_xcc_id(); b.st = st;
    if (threadIdx.x == 0) (void)xb_add(&bar[XB_XCNT(b.x)], 1u);
    return b;
}
__device__ __forceinline__ void xcd_barrier_complete(unsigned* bar, unsigned x, unsigned& nloc, unsigned& nx) {
    const unsigned G = gridDim.x * gridDim.y * gridDim.z;
    unsigned sum, cnt, mine, sp = 0u;
    for (;;) {
        sum = 0u; cnt = 0u; mine = 0u;
#pragma unroll
        for (unsigned j = 0; j < 16; ++j) { const unsigned c = xb_ld(&bar[XB_XCNT(j)]); sum += c; cnt += (c > 0u) ? 1u : 0u; mine = (j == x) ? c : mine; }
        if (sum == G) break;
        __builtin_amdgcn_s_sleep(1);
        if ((++sp & 255u) == 0u) { if (xb_ld(&bar[XB_TMO])) break; if (sp > XB_SPIN_CAP) { atomicAdd(&bar[XB_TMO], 1u); break; } }
    }
    nloc = mine > 0u ? mine : 1u; nx = cnt > 0u ? cnt : 1u;
}

__device__ __forceinline__ void xcd_barrier(const XcdBarrier& b) {
    asm volatile("s_waitcnt vmcnt(0)" ::: "memory");
    __syncthreads();
    if (threadIdx.x == 0) {
        unsigned* bar = b.bar;
        __builtin_amdgcn_s_waitcnt(0);
        unsigned nloc = b.st[0], nx = b.st[1];
        if (nloc == 0u) { xcd_barrier_complete(bar, b.x, nloc, nx); b.st[0] = nloc; b.st[1] = nx; }
        const unsigned old = xb_add(&bar[XB_XSUB(b.x)], 1u);
        const unsigned gen = old / nloc;
        if (old + 1u == (gen + 1u) * nloc) {
            __builtin_amdgcn_fence(__ATOMIC_RELEASE, "agent");
            asm volatile("s_waitcnt vmcnt(0)" ::: "memory");
            const unsigned og = xb_add(&bar[XB_TOP], 1u);
            const unsigned tg = og / nx;
            if (og + 1u == (tg + 1u) * nx) xb_add(&bar[XB_TOPGEN], 1u);
            else XB_SPIN(xb_ld(&bar[XB_TOPGEN]) == tg, bar);
            __builtin_amdgcn_fence(__ATOMIC_ACQUIRE, "agent");
            xb_add(&bar[XB_XGEN(b.x)], 1u);
            asm volatile("s_waitcnt vmcnt(0)" ::: "memory");
        } else {
            XB_SPIN(xb_ld(&bar[XB_XGEN(b.x)]) == gen, bar);
            __builtin_amdgcn_fence(__ATOMIC_ACQUIRE, "agent");
            asm volatile("s_waitcnt vmcnt(0)" ::: "memory");
        }
    }
    __syncthreads();
}

typedef LAS unsigned char* ldsp;
typedef unsigned short bf16_t;
typedef short bf16x8 __attribute__((ext_vector_type(8)));
typedef short s16x4 __attribute__((ext_vector_type(4)));
typedef float f32x4 __attribute__((ext_vector_type(4)));
typedef float f32x16 __attribute__((ext_vector_type(16)));
typedef unsigned u32x4 __attribute__((ext_vector_type(4)));
typedef unsigned u32x2 __attribute__((ext_vector_type(2)));
typedef float f32x2_t __attribute__((ext_vector_type(2)));
typedef __bf16 bf16x2_t __attribute__((ext_vector_type(2)));

constexpr int NB = 2, SEQ = 8192, M = NB * SEQ, D = 1024;
constexpr int NIN = 8208, NMAIN = 7168, NEXP = 32;
constexpr int PT_MAX = 288;
constexpr float RMS_EPS = 1e-5f;
constexpr float QK_SCALE = 0.08838834764831845f;
constexpr float C2 = QK_SCALE * 1.4426950408889634f;

constexpr size_t MiB = 1u << 20;
constexpr size_t WS_CTL = 0, CTL_ZERO_BYTES = 1 * MiB;
constexpr size_t WS_MODP = 1 * MiB;
constexpr size_t WS_MOD = 1 * MiB + 832 * 1024;
constexpr size_t WS_ROPE = 2 * MiB;
constexpr size_t WS_KM = 3 * MiB;
constexpr size_t WS_COEF = 3 * MiB + 512 * 1024;
constexpr size_t WS_DG = 3 * MiB + 640 * 1024;
constexpr size_t WS_ROUTE = 4 * MiB;
constexpr size_t WS_GLOW = 5 * MiB;
constexpr size_t WS_WIN = 8 * MiB, WS_WV = 22 * MiB, WS_WOA = 24 * MiB, WS_WOB = 26 * MiB, WS_WOUT = 28 * MiB;
constexpr size_t WS_WE1 = 32 * MiB, WS_WE2 = 160 * MiB, WS_H = 224 * MiB;
constexpr size_t WS_MQ = 256 * MiB, WS_MK = 288 * MiB, WS_VT = 320 * MiB, WS_GQ = 352 * MiB, WS_GK = 368 * MiB, WS_GV = 384 * MiB, WS_GR = 416 * MiB, WS_GA = 448 * MiB, WS_GB = 480 * MiB;
constexpr size_t WS_OA = 512 * MiB, WS_OB = 544 * MiB, WS_TG = 576 * MiB, WS_GS = 608 * MiB, WS_T1 = 640 * MiB, WS_MERGED = 704 * MiB, WS_X1 = 736 * MiB;
constexpr size_t WS_XP = 256 * MiB, WS_ACT = 400 * MiB, WS_YS = 544 * MiB, WS_END = 800 * MiB;
constexpr int CW_BAR = 4096, CW_CNT = 16384;

constexpr int LDS_BYTES = 163840, LDSCTL_OFF = 157696;
constexpr int MISC_OFF = LDSCTL_OFF;
constexpr int TEXP_OFF = LDSCTL_OFF + 128;
constexpr int ESTART_OFF = TEXP_OFF + 288 * 4;
constexpr int LH_OFF = ESTART_OFF + 40 * 4;
constexpr int LBASE_OFF = LH_OFF + 128;
constexpr int ALIST_OFF = LBASE_OFF + 128;
constexpr int QI_OFF = ALIST_OFF + 160;
constexpr int IPFX_OFF = QI_OFF + 16;
static_assert(IPFX_OFF + 516 * 4 <= LDS_BYTES, "LDS ctl map");

struct Params {
    const float *x, *c, *w_ada, *b_ada, *norm1_w, *w_in, *gla_gate_w, *gla_gate_b, *gla_norm_w, *w_o_moba, *w_o_gla, *b_merge, *w_out, *norm2_w, *w_router, *b_router, *w_exp_in, *b_exp_in, *w_exp_out, *b_exp_out, *final_norm_w;
    float* out; unsigned char* ws;
};

__device__ __forceinline__ unsigned cvtpk(float lo, float hi) { f32x2_t v = {lo, hi}; bf16x2_t b = __builtin_convertvector(v, bf16x2_t); return __builtin_bit_cast(unsigned, b); }
__device__ __forceinline__ unsigned f2bf(float f) { return cvtpk(f, 0.f) & 0xffffu; }
__device__ __forceinline__ float bf2f(unsigned b) { return __uint_as_float(b << 16); }
__device__ __forceinline__ float bflo(unsigned w) { return __uint_as_float(w << 16); }
__device__ __forceinline__ float bfhi(unsigned w) { return __uint_as_float(w & 0xffff0000u); }
__device__ __forceinline__ int crow(int reg, int h) { return (reg & 3) + 8 * (reg >> 2) + 4 * h; }
__device__ __forceinline__ float wave_sum(float v) {
#pragma unroll
    for (int o = 1; o < 64; o <<= 1) v += __shfl_xor(v, o);
    return v;
}
__device__ __forceinline__ float sigmoidf_(float z) { return 1.0f / (1.0f + __expf(-z)); }
#define MFMA32(a, b, c) __builtin_amdgcn_mfma_f32_32x32x16_bf16((a), (b), (c), 0, 0, 0)
template <int S> __device__ __forceinline__ bf16x8 pack8(const f32x16& x) {
    u32x4 p; p.x = cvtpk(x[8 * S + 0], x[8 * S + 1]); p.y = cvtpk(x[8 * S + 2], x[8 * S + 3]); p.z = cvtpk(x[8 * S + 4], x[8 * S + 5]); p.w = cvtpk(x[8 * S + 6], x[8 * S + 7]);
    return __builtin_bit_cast(bf16x8, p);
}
__device__ __forceinline__ bf16x8 cat44(s16x4 lo, s16x4 hi) { return __builtin_shufflevector(lo, hi, 0, 1, 2, 3, 4, 5, 6, 7); }

namespace pg8 {
struct EpiInProj {
    static constexpr bool PERM = true, AFTER_DRAIN = false;
    unsigned char* ws; const float* b_merge;
    __device__ __forceinline__ void operator()(const f32x4 (&acc)[2][2][4][2], const Unit& u, int wr, int wc, int fr, int fq) const {
        const int pn = u.pn; const int row0 = u.pm * BM + wr * 64 + fr; const int cl0 = wc * 32 + 8 * fq;
        bf16_t* dst; int ld = 1024, colt; int mode;
        float osc = 1.f; const float* bias = nullptr;
        if (pn < 4) { dst = (bf16_t*)(ws + WS_MQ); colt = pn * 256; mode = 0; osc = C2; }
        else if (pn < 8) { dst = (bf16_t*)(ws + WS_MK); colt = (pn - 4) * 256; mode = 0; }
        else if (pn < 10) { dst = (bf16_t*)(ws + WS_GQ); ld = 512; colt = (pn - 8) * 256; mode = 1; osc = QK_SCALE; }
        else if (pn < 12) { dst = (bf16_t*)(ws + WS_GK); ld = 512; colt = (pn - 10) * 256; mode = 2; }
        else if (pn < 16) { dst = (bf16_t*)(ws + WS_GV); colt = (pn - 12) * 256; mode = 2; }
        else if (pn < 20) { dst = (bf16_t*)(ws + WS_GR); colt = (pn - 16) * 256; mode = 3; }
        else if (pn < 24) { dst = (bf16_t*)(ws + WS_GA); colt = (pn - 20) * 256; mode = 4; bias = b_merge; }
        else { dst = (bf16_t*)(ws + WS_GB); colt = (pn - 24) * 256; mode = 4; bias = b_merge + 1024; }
        const float* rc = (const float*)(ws + WS_ROPE); const float* rs = rc + SEQ * 16;
        f32x4 bv[2][2];
#pragma unroll
        for (int bj = 0; bj < 2; ++bj)
#pragma unroll
            for (int n = 0; n < 2; ++n) bv[bj][n] = (mode == 4) ? *(const f32x4*)(bias + colt + bj * HALF + cl0 + 4 * n) : (f32x4){0.f, 0.f, 0.f, 0.f};
#pragma unroll
        for (int ai = 0; ai < 2; ++ai)
#pragma unroll
            for (int m = 0; m < 4; ++m) {
                const int row = row0 + ai * HALF + m * 16;
                f32x4 cs0 = {1.f, 1.f, 1.f, 1.f}, cs1 = cs0, sn0 = {0.f, 0.f, 0.f, 0.f}, sn1 = sn0;
                const bool rope = (mode == 0) && (wc == 0);
                if (rope) { const int pos = row & (SEQ - 1); const float* pc = rc + pos * 16 + 8 * (fq & 1); const float* ps = rs + pos * 16 + 8 * (fq & 1);
                    cs0 = *(const f32x4*)pc; cs1 = *(const f32x4*)(pc + 4); sn0 = *(const f32x4*)ps; sn1 = *(const f32x4*)(ps + 4);
                    if (fq < 2) { sn0 = -sn0; sn1 = -sn1; } }
                bf16_t* rowp = dst + (size_t)row * ld + colt + cl0;
#pragma unroll
                for (int bj = 0; bj < 2; ++bj) {
                    f32x4 v0 = acc[ai][bj][m][0], v1 = acc[ai][bj][m][1];
                    if (rope) {
                        f32x4 p0, p1;
#pragma unroll
                        for (int i = 0; i < 4; ++i) { p0[i] = __shfl_xor(v0[i], 32); p1[i] = __shfl_xor(v1[i], 32); }
                        v0 = v0 * cs0 + p0 * sn0; v1 = v1 * cs1 + p1 * sn1;
                    }
                    if (mode <= 1) { v0 = v0 * osc; v1 = v1 * osc; }
                    if (mode == 3) {
#pragma unroll
                        for (int i = 0; i < 4; ++i) { v0[i] = v0[i] * sigmoidf_(v0[i]); v1[i] = v1[i] * sigmoidf_(v1[i]); } }
                    if (mode == 4) { v0 = v0 + bv[bj][0]; v1 = v1 + bv[bj][1];
#pragma unroll
                        for (int i = 0; i < 4; ++i) { v0[i] = sigmoidf_(v0[i]); v1[i] = sigmoidf_(v1[i]); } }
                    u32x4 w; w.x = cvtpk(v0[0], v0[1]); w.y = cvtpk(v0[2], v0[3]); w.z = cvtpk(v1[0], v1[1]); w.w = cvtpk(v1[2], v1[3]);
                    *(u32x4*)(rowp + bj * HALF) = w;
                }
            }
    }
};
struct EpiT1 {
    static constexpr bool PERM = true, AFTER_DRAIN = false;
    const bf16_t* GA; float* T1;
    __device__ __forceinline__ void operator()(const f32x4 (&acc)[2][2][4][2], const Unit& u, int wr, int wc, int fr, int fq) const {
        const int row0 = u.pm * BM + wr * 64 + fr, col0 = u.pn * BM + wc * 32 + 8 * fq;
#pragma unroll
        for (int ai = 0; ai < 2; ++ai)
#pragma unroll
            for (int m = 0; m < 4; ++m) { const size_t off = (size_t)(row0 + ai * HALF + m * 16) * 1024 + col0;
#pragma unroll
                for (int bj = 0; bj < 2; ++bj) { const u32x4 g = *(const u32x4*)(GA + off + bj * HALF);
                    f32x4 v0 = acc[ai][bj][m][0], v1 = acc[ai][bj][m][1];
                    v0[0] *= bflo(g.x); v0[1] *= bfhi(g.x); v0[2] *= bflo(g.y); v0[3] *= bfhi(g.y); v1[0] *= bflo(g.z); v1[1] *= bfhi(g.z); v1[2] *= bflo(g.w); v1[3] *= bfhi(g.w);
                    *(f32x4*)(T1 + off + bj * HALF) = v0; *(f32x4*)(T1 + off + bj * HALF + 4) = v1; } }
    }
};
struct EpiMerge {
    static constexpr bool PERM = true, AFTER_DRAIN = false;
    const bf16_t* GB; const float* T1; bf16_t* O;
    __device__ __forceinline__ void operator()(const f32x4 (&acc)[2][2][4][2], const Unit& u, int wr, int wc, int fr, int fq) const {
        const int row0 = u.pm * BM + wr * 64 + fr, col0 = u.pn * BM + wc * 32 + 8 * fq;
#pragma unroll
        for (int ai = 0; ai < 2; ++ai)
#pragma unroll
            for (int m = 0; m < 4; ++m) { const size_t off = (size_t)(row0 + ai * HALF + m * 16) * 1024 + col0;
#pragma unroll
                for (int bj = 0; bj < 2; ++bj) { const u32x4 g = *(const u32x4*)(GB + off + bj * HALF);
                    const f32x4 t0 = *(const f32x4*)(T1 + off + bj * HALF), t1 = *(const f32x4*)(T1 + off + bj * HALF + 4);
                    f32x4 v0 = acc[ai][bj][m][0], v1 = acc[ai][bj][m][1];
                    v0[0] = t0[0] + v0[0] * bflo(g.x); v0[1] = t0[1] + v0[1] * bfhi(g.x); v0[2] = t0[2] + v0[2] * bflo(g.y); v0[3] = t0[3] + v0[3] * bfhi(g.y);
                    v1[0] = t1[0] + v1[0] * bflo(g.z); v1[1] = t1[1] + v1[1] * bfhi(g.z); v1[2] = t1[2] + v1[2] * bflo(g.w); v1[3] = t1[3] + v1[3] * bfhi(g.w);
                    u32x4 w; w.x = cvtpk(v0[0], v0[1]); w.y = cvtpk(v0[2], v0[3]); w.z = cvtpk(v1[0], v1[1]); w.w = cvtpk(v1[2], v1[3]);
                    *(u32x4*)(O + off + bj * HALF) = w; } }
    }
};
struct EpiX1 {
    static constexpr bool PERM = false, AFTER_DRAIN = false;
    const float* x; const float* mod; float* X1;
    __device__ __forceinline__ void operator()(const f32x4 (&acc)[2][2][4][2], const Unit& u, int wr, int wc, int fr, int fq) const {
        const int row0 = u.pm * BM + wr * 64 + fr, col0 = u.pn * BM + wc * 32 + 4 * fq;
        const float* g1 = mod + ((u.pm * BM) >> 13) * 6144 + 2048;
        f32x4 gv[2][2];
#pragma unroll
        for (int bj = 0; bj < 2; ++bj)
#pragma unroll
            for (int n = 0; n < 2; ++n) gv[bj][n] = *(const f32x4*)(g1 + col0 + bj * HALF + n * 16);
#pragma unroll
        for (int ai = 0; ai < 2; ++ai)
#pragma unroll
            for (int m = 0; m < 4; ++m) { const size_t off = (size_t)(row0 + ai * HALF + m * 16) * 1024 + col0;
#pragma unroll
                for (int bj = 0; bj < 2; ++bj)
#pragma unroll
                    for (int n = 0; n < 2; ++n) { const f32x4 xv = *(const f32x4*)(x + off + bj * HALF + n * 16);
                        *(f32x4*)(X1 + off + bj * HALF + n * 16) = xv + gv[bj][n] * acc[ai][bj][m][n]; } }
    }
};
struct EpiMoE1 {
    static constexpr bool PERM = true, AFTER_DRAIN = false;
    const float* b1; bf16_t* ACT;
    __device__ __forceinline__ void operator()(const f32x4 (&acc)[2][2][4][2], const Unit& u, int wr, int wc, int fr, int fq) const {
        const int row0 = u.pm * BM + wr * 64 + fr, col0 = u.pn * BM + wc * 32 + 8 * fq;
        const float* bp = b1 + (size_t)u.e * 2048 + col0;
        f32x4 bv[2][2];
#pragma unroll
        for (int bj = 0; bj < 2; ++bj)
#pragma unroll
            for (int n = 0; n < 2; ++n) bv[bj][n] = *(const f32x4*)(bp + bj * HALF + 4 * n);
#pragma unroll
        for (int ai = 0; ai < 2; ++ai)
#pragma unroll
            for (int m = 0; m < 4; ++m) { bf16_t* rowp = ACT + (size_t)(row0 + ai * HALF + m * 16) * 1024 + (col0 >> 1);
#pragma unroll
                for (int bj = 0; bj < 2; ++bj) { const f32x4 v0 = acc[ai][bj][m][0] + bv[bj][0], v1 = acc[ai][bj][m][1] + bv[bj][1];
                    float o[4];
#pragma unroll
                    for (int q = 0; q < 4; ++q) { const float gl = q < 2 ? v0[2 * q] : v1[2 * q - 4], ln = q < 2 ? v0[2 * q + 1] : v1[2 * q - 3];
                        const float xg = fminf(gl, 7.0f), xl = fminf(fmaxf(ln, -7.0f), 7.0f); o[q] = xg * sigmoidf_(1.702f * xg) * (xl + 1.0f); }
                    u32x2 w; w.x = cvtpk(o[0], o[1]); w.y = cvtpk(o[2], o[3]);
                    *(u32x2*)(rowp + bj * 64) = w; } }
    }
};
struct EpiMoE2 {
    static constexpr bool PERM = true, AFTER_DRAIN = false;
    const float* b2; bf16_t* YS;
    __device__ __forceinline__ void operator()(const f32x4 (&acc)[2][2][4][2], const Unit& u, int wr, int wc, int fr, int fq) const {
        const int row0 = u.pm * BM + wr * 64 + fr, col0 = u.pn * BM + wc * 32 + 8 * fq;
        const float* bp = b2 + (size_t)u.e * 1024 + col0;
        f32x4 bv[2][2];
#pragma unroll
        for (int bj = 0; bj < 2; ++bj)
#pragma unroll
            for (int n = 0; n < 2; ++n) bv[bj][n] = *(const f32x4*)(bp + bj * HALF + 4 * n);
#pragma unroll
        for (int ai = 0; ai < 2; ++ai)
#pragma unroll
            for (int m = 0; m < 4; ++m) { bf16_t* rowp = YS + (size_t)(row0 + ai * HALF + m * 16) * 1024 + col0;
#pragma unroll
                for (int bj = 0; bj < 2; ++bj) { const f32x4 v0 = acc[ai][bj][m][0] + bv[bj][0], v1 = acc[ai][bj][m][1] + bv[bj][1];
                    u32x4 w; w.x = cvtpk(v0[0], v0[1]); w.y = cvtpk(v0[2], v0[3]); w.z = cvtpk(v1[0], v1[1]); w.w = cvtpk(v1[2], v1[3]);
                    *(u32x4*)(rowp + bj * HALF) = w; } }
    }
};
struct GroupedOrder {
    int nN, G, c; const LAS int* texp; const LAS int* estart; size_t ebytes; int rep;
    __device__ __forceinline__ bool next(int i, Unit& u) const {
        const int ntiles = estart[32] >> 8; long L = (long)i * G + c; if (L >= (long)ntiles * nN * rep) return false; if (L >= (long)ntiles * nN) L -= (long)ntiles * nN;
        u.pm = (int)(L / nN); u.pn = (int)(L % nN); u.e = texp[u.pm]; return true;
    }
    __device__ __forceinline__ const char* baseA(const Gemm& g, const Unit& u, size_t tstep) const { return (const char*)g.A + (size_t)u.pm * tstep; }
    __device__ __forceinline__ const char* baseB(const Gemm& g, const Unit& u, size_t tstep) const { return (const char*)g.Bt + (size_t)u.e * ebytes + (size_t)u.pn * tstep; }
    __device__ __forceinline__ void a_ready(const Unit&) const {}
    __device__ __forceinline__ void done(const Unit&) const {}
};
}

__device__ __forceinline__ void transpose_item64(const float* W, int ldw, bf16_t* WT, int K, int nblk, LAS float* scr, int item, int lane) {
    const int kb = item / nblk, nb = item % nblk, k0 = 64 * kb, n0 = 64 * nb;
    const float* src = W + (size_t)(k0 + (lane >> 4)) * ldw + n0 + 4 * (lane & 15);
    f32x4 v[16];
#pragma unroll
    for (int i = 0; i < 16; ++i) v[i] = *(const f32x4*)(src + (size_t)(4 * i) * ldw);
#pragma unroll
    for (int i = 0; i < 16; ++i) { LAS float* d = scr + ((lane >> 4) + 4 * i) * 65 + 4 * (lane & 15); d[0] = v[i][0]; d[1] = v[i][1]; d[2] = v[i][2]; d[3] = v[i][3]; }
    asm volatile("s_waitcnt lgkmcnt(0)" ::: "memory");
    const int c = lane & 7;
#pragma unroll
    for (int j = 0; j < 8; ++j) { const int n = (lane >> 3) + 8 * j; const LAS float* s = scr + (8 * c) * 65 + n;
        u32x4 o; o.x = cvtpk(s[0 * 65], s[1 * 65]); o.y = cvtpk(s[2 * 65], s[3 * 65]); o.z = cvtpk(s[4 * 65], s[5 * 65]); o.w = cvtpk(s[6 * 65], s[7 * 65]);
        *(u32x4*)(WT + (size_t)(n0 + n) * K + k0 + 8 * c) = o; }
    asm volatile("s_waitcnt lgkmcnt(0)" ::: "memory");
}
__device__ __forceinline__ void p0_prologue(const Params& P, ldsp lds, int tid, int lane, int wave, int bid, int G) {
    unsigned char* ws = P.ws;
    LAS float* scr = (LAS float*)(lds + wave * 16640);
    const int gw = bid * 8 + wave, NGW = G * 8;
    constexpr int I_S0 = 16 * 32, I_S1 = 16 * 48, I_S2 = 16 * 32, I_S3 = 16 * 16, I_SQ = 16 * 16, I_E1 = 16 * 32, I_E2 = 16 * 16;
    constexpr int NITEMS = I_S0 + I_S1 + I_S2 + I_S3 + 3 * I_SQ + 32 * I_E1 + 32 * I_E2;
    for (int it = gw; it < NITEMS; it += NGW) {
        int r = it;
        if (r < I_S0) { transpose_item64(P.w_in, NIN, (bf16_t*)(ws + WS_WIN), 1024, 32, scr, r, lane); continue; } r -= I_S0;
        if (r < I_S1) { transpose_item64(P.w_in + 3072, NIN, (bf16_t*)(ws + WS_WIN) + (size_t)2048 * 1024, 1024, 48, scr, r, lane); continue; } r -= I_S1;
        if (r < I_S2) { transpose_item64(P.w_in + 6160, NIN, (bf16_t*)(ws + WS_WIN) + (size_t)5120 * 1024, 1024, 32, scr, r, lane); continue; } r -= I_S2;
        if (r < I_S3) { transpose_item64(P.w_in + 2048, NIN, (bf16_t*)(ws + WS_WV), 1024, 16, scr, r, lane); continue; } r -= I_S3;
        if (r < I_SQ) { transpose_item64(P.w_o_moba, 1024, (bf16_t*)(ws + WS_WOA), 1024, 16, scr, r, lane); continue; } r -= I_SQ;
        if (r < I_SQ) { transpose_item64(P.w_o_gla, 1024, (bf16_t*)(ws + WS_WOB), 1024, 16, scr, r, lane); continue; } r -= I_SQ;
        if (r < I_SQ) { transpose_item64(P.w_out, 1024, (bf16_t*)(ws + WS_WOUT), 1024, 16, scr, r, lane); continue; } r -= I_SQ;
        if (r < 32 * I_E1) { const int e = r / I_E1; transpose_item64(P.w_exp_in + (size_t)e * 1024 * 2048, 2048, (bf16_t*)(ws + WS_WE1) + (size_t)e * 2048 * 1024, 1024, 32, scr, r % I_E1, lane); continue; } r -= 32 * I_E1;
        { const int e = r / I_E2; transpose_item64(P.w_exp_out + (size_t)e * 1024 * 1024, 1024, (bf16_t*)(ws + WS_WE2) + (size_t)e * 1024 * 1024, 1024, 16, scr, r % I_E2, lane); }
    }
    float* MODP = (float*)(ws + WS_MODP);
    for (int it = gw; it < 96 * 16; it += NGW) {
        const int g = it % 96, kc = it / 96, col = 64 * g + lane;
        const float c0 = P.c[64 * kc + lane], c1 = P.c[1024 + 64 * kc + lane];
        const float s0 = c0 * sigmoidf_(c0), s1 = c1 * sigmoidf_(c1);
        const float* wp = P.w_ada + (size_t)(64 * kc) * 6144 + col;
        float a0 = 0.f, a1 = 0.f;
#pragma unroll 16
        for (int kk = 0; kk < 64; ++kk) { const float w = wp[(size_t)kk * 6144]; a0 += __shfl(s0, kk) * w; a1 += __shfl(s1, kk) * w; }
        MODP[(kc * 2 + 0) * 6144 + col] = a0; MODP[(kc * 2 + 1) * 6144 + col] = a1;
    }
    { const int g = bid * 512 + tid;
      if (g < SEQ * 16) { const int pos = g >> 4, j = g & 15; const float inv = powf(500000.0f, -(float)j * (1.0f / 16.0f)); const float ang = (float)pos * inv;
          float* rc = (float*)(ws + WS_ROPE); rc[g] = cosf(ang); rc[SEQ * 16 + g] = sinf(ang); } }
}

__device__ __forceinline__ void p1_norm1(const Params& P, ldsp lds, int tid, int lane, int wave, int bid, int G) {
    unsigned char* ws = P.ws;
    const float* MODP = (const float*)(ws + WS_MODP);
    LAS float* A1 = (LAS float*)lds;
    LAS float* B1 = A1 + 2048;
    LAS float* WL = B1 + 2048;
    for (int idx = tid; idx < 2048; idx += 512) { const int b = idx >> 10, c = idx & 1023;
        float sh = P.b_ada[c], sc = P.b_ada[1024 + c];
#pragma unroll
        for (int kc = 0; kc < 16; ++kc) { sh += MODP[(kc * 2 + b) * 6144 + c]; sc += MODP[(kc * 2 + b) * 6144 + 1024 + c]; }
        A1[idx] = P.norm1_w[c] * (1.0f + sc); B1[idx] = sh; }
    for (int idx = tid; idx < 16384; idx += 512) { const int k = idx >> 4, t = idx & 15; WL[t * 1024 + k] = P.w_in[(size_t)k * NIN + 6144 + t]; }
    { const int g = bid * 512 + tid;
      if (g < 2 * 6144) { const int b = g / 6144, n = g % 6144; float s = P.b_ada[n];
#pragma unroll
          for (int kc = 0; kc < 16; ++kc) s += MODP[(kc * 2 + b) * 6144 + n];
          ((float*)(ws + WS_MOD))[g] = s; }
      else if (g < 2 * 6144 + 2048) { const int q = g - 2 * 6144, b = q >> 10, c = q & 1023; float sh = P.b_ada[3072 + c], sc = P.b_ada[4096 + c];
#pragma unroll
          for (int kc = 0; kc < 16; ++kc) { sh += MODP[(kc * 2 + b) * 6144 + 3072 + c]; sc += MODP[(kc * 2 + b) * 6144 + 4096 + c]; }
          float* CO = (float*)(ws + WS_COEF); CO[(b * 2 + 0) * 1024 + c] = P.norm2_w[c] * (1.0f + sc); CO[(b * 2 + 1) * 1024 + c] = sh; } }
    __syncthreads();
    const int gw = bid * 8 + wave, NGW = G * 8;
    bf16_t* H = (bf16_t*)(ws + WS_H); float* GLOW = (float*)(ws + WS_GLOW);
    for (int m = gw; m < M; m += NGW) {
        const int b = m >> 13;
        const f32x4* xr = (const f32x4*)(P.x + (size_t)m * 1024) + lane;
        f32x4 v[4]; float ss = 0.f;
#pragma unroll
        for (int j = 0; j < 4; ++j) { v[j] = xr[64 * j]; ss += (v[j][0] * v[j][0] + v[j][1] * v[j][1]) + (v[j][2] * v[j][2] + v[j][3] * v[j][3]); }
        const float rstd = 1.0f / sqrtf(wave_sum(ss) * (1.0f / 1024.0f) + RMS_EPS);
#pragma unroll
        for (int j = 0; j < 4; ++j) { const f32x4 a = *(const LAS f32x4*)(A1 + b * 1024 + 4 * lane + 256 * j), bb = *(const LAS f32x4*)(B1 + b * 1024 + 4 * lane + 256 * j);
            v[j] = v[j] * rstd * a + bb;
            u32x2 w; w.x = cvtpk(v[j][0], v[j][1]); w.y = cvtpk(v[j][2], v[j][3]);
            *(u32x2*)(H + (size_t)m * 1024 + 4 * lane + 256 * j) = w; }
        float mine = 0.f;
#pragma unroll 2
        for (int t = 0; t < 16; ++t) { float a = 0.f;
#pragma unroll
            for (int j = 0; j < 4; ++j) { const f32x4 wv = *(const LAS f32x4*)(WL + t * 1024 + 4 * lane + 256 * j); a += (v[j][0] * wv[0] + v[j][1] * wv[1]) + (v[j][2] * wv[2] + v[j][3] * wv[3]); }
            const float s = wave_sum(a); if (lane == t) mine = s; }
        if (lane < 16) GLOW[(size_t)m * 16 + lane] = mine;
    }
}

__device__ __forceinline__ void kmean_item(const Params& P, ldsp lds, int item, int tid) {
    const int blk = item & 31, bh = item >> 5, b = bh >> 3, hd = bh & 7;
    const bf16_t* MK = (const bf16_t*)(P.ws + WS_MK);
    const int c = tid & 15, rg = tid >> 4;
    float a[8];
#pragma unroll
    for (int j = 0; j < 8; ++j) a[j] = 0.f;
    const bf16_t* src = MK + (size_t)(b * SEQ + blk * 256 + rg * 8) * 1024 + hd * 128 + c * 8;
#pragma unroll
    for (int i = 0; i < 8; ++i) { const u32x4 v = *(const u32x4*)(src + (size_t)i * 1024);
        a[0] += bflo(v.x); a[1] += bfhi(v.x); a[2] += bflo(v.y); a[3] += bfhi(v.y); a[4] += bflo(v.z); a[5] += bfhi(v.z); a[6] += bflo(v.w); a[7] += bfhi(v.w); }
    LAS float* part = (LAS float*)lds;
#pragma unroll
    for (int j = 0; j < 8; ++j) part[rg * 128 + c * 8 + j] = a[j];
    __syncthreads();
    if (tid < 128) { float s = 0.f;
#pragma unroll 8
        for (int g = 0; g < 32; ++g) s += part[g * 128 + tid];
        s *= (1.0f / 256.0f);
        const unsigned hi = f2bf(s); const unsigned lo = f2bf(s - bf2f(hi));
        bf16_t* KMH = (bf16_t*)(P.ws + WS_KM); KMH[item * 128 + tid] = (bf16_t)hi; KMH[16 * 32 * 128 + item * 128 + tid] = (bf16_t)lo; }
    __syncthreads();
}

constexpr int GL_Q = 0;
constexpr int GL_KR = 17408;
constexpr int GL_KT = 34816;
constexpr int GL_VT = 53248;
constexpr int GL_GLOW = 90112;
constexpr int GL_CS = 94208;
constexpr int GL_BL = 96256;
constexpr int GL_RS = 96768;
__device__ __forceinline__ void gla_prep(const Params& P, ldsp lds, int tok0, int hg, bool need_q, int tid) {
    const unsigned char* ws = P.ws;
    if (tid < 256) { const f32x4 v = *(const f32x4*)((const float*)(ws + WS_GLOW) + (size_t)tok0 * 16 + tid * 4); *(LAS f32x4*)(lds + GL_GLOW + tid * 16) = v; }
    __syncthreads();
    const int d = tid & 127, rq = tid >> 7;
    float gw[16];
#pragma unroll
    for (int t = 0; t < 16; ++t) gw[t] = P.gla_gate_w[t * 512 + 128 * hg + d];
    const float gb = P.gla_gate_b[128 * hg + d];
    float bl[16]; float run = 0.f;
    const LAS float* glw = (const LAS float*)(lds + GL_GLOW);
#pragma unroll
    for (int i = 0; i < 16; ++i) { const int row = 16 * rq + i; float z = gb;
#pragma unroll
        for (int t4 = 0; t4 < 4; ++t4) { const f32x4 gv = *(const LAS f32x4*)(glw + row * 16 + 4 * t4); z += gv[0] * gw[4 * t4] + gv[1] * gw[4 * t4 + 1] + gv[2] * gw[4 * t4 + 2] + gv[3] * gw[4 * t4 + 3]; }
        const float ls = fminf(z, 0.f) - log1pf(__expf(-fabsf(z)));
        run += ls * (1.0f / 16.0f); bl[i] = run; }
    LAS float* CS = (LAS float*)(lds + GL_CS);
    CS[rq * 128 + d] = run;
    __syncthreads();
    float pre = 0.f, tot = 0.f;
#pragma unroll
    for (int q = 0; q < 4; ++q) { const float c = CS[q * 128 + d]; tot += c; if (q < rq) pre += c; }
    if (rq == 0) ((LAS float*)(lds + GL_BL))[d] = tot;
    const bf16_t* GK = (const bf16_t*)(ws + WS_GK); const bf16_t* GQ = (const bf16_t*)(ws + WS_GQ);
    LAS bf16_t* KR = (LAS bf16_t*)(lds + GL_KR); LAS bf16_t* KT = (LAS bf16_t*)(lds + GL_KT); LAS bf16_t* QI = (LAS bf16_t*)(lds + GL_Q);
#pragma unroll
    for (int i = 0; i < 16; ++i) { const int row = 16 * rq + i; const float bi = pre + bl[i];
        const float kv = bf2f(GK[(size_t)(tok0 + row) * 512 + 128 * hg + d]) * __expf(tot - bi);
        const bf16_t kb = (bf16_t)f2bf(kv); KR[row * 136 + d] = kb; KT[d * 72 + row] = kb;
        if (need_q) { const float qv = bf2f(GQ[(size_t)(tok0 + row) * 512 + 128 * hg + d]) * __expf(bi - tot); QI[row * 136 + d] = (bf16_t)f2bf(qv); } }
    { const int dv = tid & 255, half = tid >> 8; const bf16_t* GV = (const bf16_t*)(ws + WS_GV) + (size_t)(tok0 + 32 * half) * 1024 + 256 * hg + dv;
      unsigned pk[16];
#pragma unroll
      for (int c2 = 0; c2 < 16; ++c2) { const unsigned lo = GV[(size_t)(2 * c2) * 1024], hi = GV[(size_t)(2 * c2 + 1) * 1024]; pk[c2] = lo | (hi << 16); }
#pragma unroll
      for (int q = 0; q < 4; ++q) { u32x4 w; w.x = pk[4 * q]; w.y = pk[4 * q + 1]; w.z = pk[4 * q + 2]; w.w = pk[4 * q + 3]; *(LAS u32x4*)(lds + GL_VT + dv * 144 + 64 * half + 16 * q) = w; } }
    __syncthreads();
}
template <bool PHASE_C>
__device__ __forceinline__ void gla_unit(const Params& P, ldsp lds, int bh8, int g, int tid_in, int lane_in, int wave) {
    unsigned char* ws = P.ws;
    const int b = bh8 >> 2, hg = bh8 & 3;
    int tid = tid_in, lane = lane_in; int r = lane & 31, h = lane >> 5;
    f32x16 S[4];
    float* GS = (float*)(ws + WS_GS) + (size_t)(bh8 * 32 + g) * 128 * 256;
#pragma unroll
    for (int dkb = 0; dkb < 4; ++dkb)
#pragma unroll
        for (int reg = 0; reg < 16; ++reg) S[dkb][reg] = PHASE_C ? GS[(size_t)(32 * dkb + crow(reg, h)) * 256 + 32 * wave + r] : 0.f;
    float bsum = 0.f;
    const LAS float* BL = (const LAS float*)(lds + GL_BL);
    for (int ch = 0; ch < 4; ++ch) {
        tid = tid_in; asm volatile("" : "+v"(tid)); lane = tid & 63; r = lane & 31; h = lane >> 5;
        const int tok0 = b * SEQ + (g * 4 + ch) * 64;
        gla_prep(P, lds, tok0, hg, PHASE_C, tid);
#pragma unroll
        for (int dkb = 0; dkb < 4; ++dkb)
#pragma unroll
            for (int reg = 0; reg < 16; ++reg) S[dkb][reg] *= __expf(BL[32 * dkb + crow(reg, h)]);
        if (tid < 128) bsum += BL[tid];
        __builtin_amdgcn_sched_barrier(0);
        if (PHASE_C) {
            f32x16 at00, at01, at11;
#pragma unroll
            for (int i = 0; i < 16; ++i) { at00[i] = 0.f; at01[i] = 0.f; at11[i] = 0.f; }
#pragma unroll
            for (int s = 0; s < 8; ++s) {
                const bf16x8 ka0 = *(const LAS bf16x8*)(lds + GL_KR + r * 272 + 32 * s + 16 * h), ka1 = *(const LAS bf16x8*)(lds + GL_KR + (32 + r) * 272 + 32 * s + 16 * h);
                const bf16x8 qb0 = *(const LAS bf16x8*)(lds + GL_Q + r * 272 + 32 * s + 16 * h), qb1 = *(const LAS bf16x8*)(lds + GL_Q + (32 + r) * 272 + 32 * s + 16 * h);
                at00 = MFMA32(ka0, qb0, at00); at01 = MFMA32(ka0, qb1, at01); at11 = MFMA32(ka1, qb1, at11);
                if (s & 1) __builtin_amdgcn_sched_barrier(0);
            }
#pragma unroll
            for (int reg = 0; reg < 16; ++reg) { if (crow(reg, h) > r) { at00[reg] = 0.f; at11[reg] = 0.f; } }
            f32x16 ot0, ot1;
#pragma unroll
            for (int i = 0; i < 16; ++i) { ot0[i] = 0.f; ot1[i] = 0.f; }
#pragma unroll
            for (int dkb = 0; dkb < 4; ++dkb) {
                const bf16x8 sa0 = pack8<0>(S[dkb]), sa1 = pack8<1>(S[dkb]);
#pragma unroll
                for (int s = 0; s < 2; ++s) {
                    const int co = (32 * dkb + 16 * s + 4 * h) * 2;
                    const bf16x8 q0 = cat44(*(const LAS s16x4*)(lds + GL_Q + r * 272 + co), *(const LAS s16x4*)(lds + GL_Q + r * 272 + co + 16));
                    const bf16x8 q1 = cat44(*(const LAS s16x4*)(lds + GL_Q + (32 + r) * 272 + co), *(const LAS s16x4*)(lds + GL_Q + (32 + r) * 272 + co + 16));
                    ot0 = MFMA32(s == 0 ? sa0 : sa1, q0, ot0); ot1 = MFMA32(s == 0 ? sa0 : sa1, q1, ot1);
                }
                __builtin_amdgcn_sched_barrier(0);
            }
            {
                const bf16x8 p00a = pack8<0>(at00), p00b = pack8<1>(at00), p01a = pack8<0>(at01), p01b = pack8<1>(at01), p11a = pack8<0>(at11), p11b = pack8<1>(at11);
                const int vrow = GL_VT + (32 * wave + r) * 144;
#pragma unroll
                for (int s = 0; s < 2; ++s) {
                    const int c0 = (16 * s + 4 * h) * 2, c1 = (32 + 16 * s + 4 * h) * 2;
                    const bf16x8 v0 = cat44(*(const LAS s16x4*)(lds + vrow + c0), *(const LAS s16x4*)(lds + vrow + c0 + 16));
                    const bf16x8 v1 = cat44(*(const LAS s16x4*)(lds + vrow + c1), *(const LAS s16x4*)(lds + vrow + c1 + 16));
                    ot0 = MFMA32(v0, s == 0 ? p00a : p00b, ot0);
                    ot1 = MFMA32(v0, s == 0 ? p01a : p01b, ot1);
                    ot1 = MFMA32(v1, s == 0 ? p11a : p11b, ot1);
                }
            }
            __builtin_amdgcn_sched_barrier(0);
            LAS float* RS = (LAS float*)(lds + GL_RS);
            float q0 = 0.f, q1 = 0.f;
#pragma unroll
            for (int i = 0; i < 16; ++i) { q0 += ot0[i] * ot0[i]; q1 += ot1[i] * ot1[i]; }
            q0 += __shfl_xor(q0, 32); q1 += __shfl_xor(q1, 32);
            if (h == 0) { RS[wave * 64 + r] = q0; RS[wave * 64 + 32 + r] = q1; }
            __syncthreads();
            float t0 = 0.f, t1 = 0.f;
#pragma unroll
            for (int w = 0; w < 8; ++w) { t0 += RS[w * 64 + r]; t1 += RS[w * 64 + 32 + r]; }
            const float rs0 = 1.0f / sqrtf(t0 * (1.0f / 256.0f) + RMS_EPS), rs1 = 1.0f / sqrtf(t1 * (1.0f / 256.0f) + RMS_EPS);
            const bf16_t* GR = (const bf16_t*)(ws + WS_GR); bf16_t* OB = (bf16_t*)(ws + WS_OB);
#pragma unroll
            for (int ib = 0; ib < 2; ++ib) {
                const size_t rowoff = (size_t)(tok0 + 32 * ib + r) * 1024 + 256 * hg + 32 * wave;
#pragma unroll
                for (int rq = 0; rq < 4; ++rq) { const int dvl = 8 * rq + 4 * h;
                    const u32x2 gr = *(const u32x2*)(GR + rowoff + dvl);
                    const f32x4 nw = *(const f32x4*)(P.gla_norm_w + 32 * wave + dvl);
                    const float rs = ib == 0 ? rs0 : rs1;
                    float o[4];
#pragma unroll
                    for (int i = 0; i < 4; ++i) o[i] = (ib == 0 ? ot0[4 * rq + i] : ot1[4 * rq + i]) * rs * nw[i];
                    o[0] *= bflo(gr.x); o[1] *= bfhi(gr.x); o[2] *= bflo(gr.y); o[3] *= bfhi(gr.y);
                    u32x2 w; w.x = cvtpk(o[0], o[1]); w.y = cvtpk(o[2], o[3]);
                    *(u32x2*)(OB + rowoff + dvl) = w; }
            }
        }
        __builtin_amdgcn_sched_barrier(0);
#pragma unroll
        for (int s = 0; s < 4; ++s) {
            const bf16x8 vb = *(const LAS bf16x8*)(lds + GL_VT + (32 * wave + r) * 144 + 32 * s + 16 * h);
#pragma unroll
            for (int dkb = 0; dkb < 4; ++dkb) { const bf16x8 ka = *(const LAS bf16x8*)(lds + GL_KT + (32 * dkb + r) * 144 + 32 * s + 16 * h); S[dkb] = MFMA32(ka, vb, S[dkb]); }
            __builtin_amdgcn_sched_barrier(0);
        }
        __syncthreads();
    }
    if (!PHASE_C) {
        float* TG = (float*)(ws + WS_TG) + (size_t)(bh8 * 32 + g) * 128 * 256;
#pragma unroll
        for (int dkb = 0; dkb < 4; ++dkb)
#pragma unroll
            for (int reg = 0; reg < 16; ++reg) TG[(size_t)(32 * dkb + crow(reg, h)) * 256 + 32 * wave + r] = S[dkb][reg];
        if (tid < 128) ((float*)(ws + WS_DG))[(bh8 * 32 + g) * 128 + tid] = __expf(bsum);
    }
}
__device__ __forceinline__ void gla_scan(const Params& P, int tid, int bid) {
    const float* TG = (const float*)(P.ws + WS_TG); const float* DG = (const float*)(P.ws + WS_DG); float* GS = (float*)(P.ws + WS_GS);
#pragma unroll
    for (int rep = 0; rep < 2; ++rep) {
        const int e = bid * 512 + tid + rep * 131072; const int bh8 = e >> 15, dk = (e >> 8) & 127, dv = e & 255;
        float G = 0.f;
        for (int g = 0; g < 32; ++g) { const size_t off = ((size_t)(bh8 * 32 + g) * 128 + dk) * 256 + dv;
            GS[off] = G; G = DG[(bh8 * 32 + g) * 128 + dk] * G + TG[off]; }
    }
}

constexpr size_t WS_PART = 640 * MiB;
constexpr size_t WS_ML = 768 * MiB;
constexpr size_t WS_LIST = 772 * MiB;
constexpr int CW_LCNT = 32768;
constexpr int CW_QHEAD = 40960;
constexpr int AT2_K = 0;
constexpr int AT2_V = 69632;
__device__ __forceinline__ void moba_select_unit(const Params& P, ldsp lds, int b, int hd, int blk, int tid, int lane, int wave) {
    unsigned char* ws = P.ws;
    const int r = lane & 31, h = lane >> 5, bh = b * 8 + hd;
    LAS int* HB = (LAS int*)lds; LAS int* GBASE = HB + 32;
    if (tid < 32) HB[tid] = 0;
    unsigned sel = 0u;
    if (blk > 0) {
        const bf16_t* MQ = (const bf16_t*)(ws + WS_MQ);
        const int tokq = b * SEQ + 256 * blk + 32 * wave + r;
        bf16x8 qr[8];
#pragma unroll
        for (int s = 0; s < 8; ++s) qr[s] = *(const bf16x8*)(MQ + (size_t)tokq * 1024 + 128 * hd + 16 * s + 8 * h);
        const bf16_t* KMH = (const bf16_t*)(ws + WS_KM) + (size_t)(bh * 32 + r) * 128; const bf16_t* KML = KMH + 16 * 32 * 128;
        f32x16 gt;
#pragma unroll
        for (int i = 0; i < 16; ++i) gt[i] = 0.f;
#pragma unroll
        for (int s = 0; s < 8; ++s) { const bf16x8 a = *(const bf16x8*)(KMH + 16 * s + 8 * h), a2 = *(const bf16x8*)(KML + 16 * s + 8 * h); gt = MFMA32(a, qr[s], gt); gt = MFMA32(a2, qr[s], gt); }
#pragma unroll
        for (int round = 0; round < 3; ++round) {
            float best = -INFINITY; int bn = 64;
#pragma unroll
            for (int reg = 0; reg < 16; ++reg) { const int n = crow(reg, h); const bool ok = (n < blk) && !((sel >> n) & 1u); if (ok && gt[reg] > best) { best = gt[reg]; bn = n; } }
            const float ob = __shfl_xor(best, 32); const int on = __shfl_xor(bn, 32);
            if (ob > best || (ob == best && on < bn)) { best = ob; bn = on; }
            if (bn < 64) sel |= 1u << bn;
        }
    }
    __syncthreads();
    int pn[3] = {0, 0, 0}, pr[3] = {0, 0, 0}; int nsel = 0;
    if (h == 0) { unsigned mm = sel;
#pragma unroll
        for (int s = 0; s < 3; ++s) if (mm) { const int n = __builtin_ctz(mm); mm &= mm - 1; pn[s] = n; pr[s] = __hip_atomic_fetch_add(HB + n, 1, __ATOMIC_RELAXED, __HIP_MEMORY_SCOPE_WORKGROUP); nsel = s + 1; } }
    __syncthreads();
    if (tid < 32) { const int c = HB[tid]; if (c > 0) GBASE[tid] = (int)atomicAdd((unsigned*)(ws + WS_CTL) + CW_LCNT + bh * 32 + tid, (unsigned)c); }
    __syncthreads();
    if (h == 0) { const int ql = 256 * blk + 32 * wave + r; unsigned* LIST = (unsigned*)(ws + WS_LIST); float* ML = (float*)(ws + WS_ML);
#pragma unroll
        for (int s = 0; s < 3; ++s) {
            if (s < nsel) LIST[(size_t)(bh * 32 + pn[s]) * 8192 + GBASE[pn[s]] + pr[s]] = (unsigned)ql | ((unsigned)s << 13);
            else { const size_t mi = ((size_t)(bh * 8192 + ql) * 4 + s) * 2; ML[mi] = -1e30f; ML[mi + 1] = 0.f; } } }
    __syncthreads();
}
__device__ __forceinline__ void moba_item_table(const Params& P, ldsp lds, int lane, int wave) {
    LAS int* IPFX = (LAS int*)(lds + IPFX_OFF);
    if (wave == 0) { const unsigned* LC = (const unsigned*)(P.ws + WS_CTL) + CW_LCNT;
        int v[8]; int s = 0;
#pragma unroll
        for (int j = 0; j < 8; ++j) { const int o = lane * 8 + j; const int cnt = (int)__hip_atomic_load(LC + (o & 15) * 32 + (o >> 4), __ATOMIC_RELAXED, __HIP_MEMORY_SCOPE_AGENT);
            const int nch = 1 + ((cnt + 255) >> 8); v[j] = (nch + 3) >> 2; s += v[j]; }
        int incl = s;
#pragma unroll
        for (int o = 1; o < 64; o <<= 1) { const int t = __shfl_up(incl, o); if (lane >= o) incl += t; }
        int excl = incl - s;
#pragma unroll
        for (int j = 0; j < 8; ++j) { IPFX[lane * 8 + j] = excl; excl += v[j]; }
        if (lane == 63) IPFX[512] = incl; }
    __syncthreads();
}
__device__ __forceinline__ void moba_item(const Params& P, ldsp lds, int ia, int tid_in, int wave) {
    unsigned char* ws = P.ws;
    const LAS int* IPFX = (const LAS int*)(lds + IPFX_OFF);
    int lo = 0, hi = 512;
    while (hi - lo > 1) { const int mid = (lo + hi) >> 1; if (IPFX[mid] <= ia) lo = mid; else hi = mid; }
    const int o_ = __builtin_amdgcn_readfirstlane(lo);
    const int n = o_ >> 4, bh = o_ & 15, b = bh >> 3, hd = bh & 7;
    const int cnt = __builtin_amdgcn_readfirstlane((int)__hip_atomic_load((const unsigned*)(ws + WS_CTL) + CW_LCNT + bh * 32 + n, __ATOMIC_RELAXED, __HIP_MEMORY_SCOPE_AGENT));
    const int nch = 1 + ((cnt + 255) >> 8); const int c0 = 4 * (ia - IPFX[o_]); const int c1 = (c0 + 4 < nch) ? c0 + 4 : nch;
    const bf16_t* MQ = (const bf16_t*)(ws + WS_MQ);
    {
        int tid = tid_in; asm volatile("" : "+v"(tid));
        const bf16_t* Kg = (const bf16_t*)(ws + WS_MK) + (size_t)(b * SEQ + 256 * n) * 1024 + 128 * hd;
        const bf16_t* Vg = (const bf16_t*)(ws + WS_VT) + (size_t)(128 * hd) * M + (size_t)b * SEQ + 256 * n;
#pragma unroll
        for (int hf = 0; hf < 2; ++hf) {
            u32x4 kv[4], vv[4];
#pragma unroll
            for (int i = 0; i < 4; ++i) { const int p = tid + 512 * (4 * hf + i); kv[i] = *(const u32x4*)(Kg + (size_t)(p >> 4) * 1024 + 8 * (p & 15)); vv[i] = *(const u32x4*)(Vg + (size_t)(p >> 5) * M + 8 * (p & 31)); }
#pragma unroll
            for (int i = 0; i < 4; ++i) { const int p = tid + 512 * (4 * hf + i);
                *(LAS u32x4*)(lds + AT2_K + (p >> 4) * 272 + 16 * (p & 15)) = kv[i];
                *(LAS u32x2*)(lds + AT2_V + (p >> 5) * 520 + 16 * (p & 31)) = (u32x2){vv[i].x, vv[i].y}; *(LAS u32x2*)(lds + AT2_V + (p >> 5) * 520 + 16 * (p & 31) + 8) = (u32x2){vv[i].z, vv[i].w}; }
        }
    }
    __syncthreads();
    for (int c = c0; c < c1; ++c) {
        int tid = tid_in; asm volatile("" : "+v"(tid)); const int lane = tid & 63, r = lane & 31, h = lane >> 5;
        const bool own = (c == 0);
        const int idx0 = (c - 1) * 256 + 32 * wave;
        if (!own && idx0 >= cnt) continue;
        int ql, slot; bool valid = true;
        if (own) { ql = 256 * n + 32 * wave + r; slot = 3; }
        else { const int idx = idx0 + r; valid = idx < cnt; const unsigned e = ((const unsigned*)(ws + WS_LIST))[(size_t)(bh * 32 + n) * 8192 + (valid ? idx : cnt - 1)]; ql = (int)(e & 8191u); slot = (int)(e >> 13); }
        bf16x8 qr[8];
        { const bf16_t* qp = MQ + (size_t)(b * SEQ + ql) * 1024 + 128 * hd + 8 * h;
#pragma unroll
          for (int s = 0; s < 8; ++s) qr[s] = *(const bf16x8*)(qp + 16 * s); }
        f32x16 o[4];
#pragma unroll
        for (int db = 0; db < 4; ++db)
#pragma unroll
            for (int i = 0; i < 16; ++i) o[db][i] = 0.f;
        float mrun = -1e30f, lrun = 0.f;
        const int tmax = own ? ((32 * wave + 31) >> 6) : 3;
        for (int t = 0; t <= tmax; ++t) {
            f32x16 p0, p1;
#pragma unroll
            for (int i = 0; i < 16; ++i) { p0[i] = 0.f; p1[i] = 0.f; }
            const int krow = AT2_K + (64 * t + r) * 272 + 16 * h;
#pragma unroll
            for (int s = 0; s < 8; ++s) {
                const bf16x8 ka = *(const LAS bf16x8*)(lds + krow + 32 * s), kb = *(const LAS bf16x8*)(lds + krow + 32 * 272 + 32 * s);
                p0 = MFMA32(ka, qr[s], p0); p1 = MFMA32(kb, qr[s], p1);
            }
            if (own) { const int qloc = 32 * wave + r;
#pragma unroll
                for (int reg = 0; reg < 16; ++reg) { const int kl = 64 * t + crow(reg, h); if (kl > qloc) p0[reg] = -INFINITY; if (kl + 32 > qloc) p1[reg] = -INFINITY; } }
            float tm = fmaxf(p0[0], p1[0]);
#pragma unroll
            for (int reg = 1; reg < 16; ++reg) tm = fmaxf(tm, fmaxf(p0[reg], p1[reg]));
            tm = fmaxf(tm, __shfl_xor(tm, 32));
            const float mnew = fmaxf(mrun, tm);
            const float f = __builtin_amdgcn_exp2f(mrun - mnew);
            mrun = mnew;
            float ps = 0.f;
#pragma unroll
            for (int reg = 0; reg < 16; ++reg) { p0[reg] = __builtin_amdgcn_exp2f(p0[reg] - mnew); p1[reg] = __builtin_amdgcn_exp2f(p1[reg] - mnew); ps += p0[reg] + p1[reg]; }
            lrun = lrun * f + ps;
            if (!__all(f == 1.0f)) {
#pragma unroll
                for (int db = 0; db < 4; ++db)
#pragma unroll
                    for (int i = 0; i < 16; ++i) o[db][i] *= f; }
            const bf16x8 pf0 = pack8<0>(p0), pf1 = pack8<1>(p0), pf2 = pack8<0>(p1), pf3 = pack8<1>(p1);
#pragma unroll
            for (int db = 0; db < 4; ++db) {
                const int vrow = AT2_V + (32 * db + r) * 520 + (64 * t + 4 * h) * 2;
#pragma unroll
                for (int ks = 0; ks < 4; ++ks) {
                    const bf16x8 vf = cat44(*(const LAS s16x4*)(lds + vrow + 32 * ks), *(const LAS s16x4*)(lds + vrow + 32 * ks + 16));
                    o[db] = MFMA32(vf, ks == 0 ? pf0 : ks == 1 ? pf1 : ks == 2 ? pf2 : pf3, o[db]);
                }
            }
        }
        lrun += __shfl_xor(lrun, 32);
        const float inv = 1.0f / lrun;
        if (valid) {
            const size_t pi = (size_t)(bh * 8192 + ql) * 4 + slot;
            bf16_t* PO = (bf16_t*)(ws + WS_PART) + pi * 128;
#pragma unroll
            for (int db = 0; db < 4; ++db)
#pragma unroll
                for (int rq = 0; rq < 4; ++rq) { u32x2 w; w.x = cvtpk(o[db][4 * rq] * inv, o[db][4 * rq + 1] * inv); w.y = cvtpk(o[db][4 * rq + 2] * inv, o[db][4 * rq + 3] * inv);
                    *(u32x2*)(PO + 32 * db + 8 * rq + 4 * h) = w; }
            if (h == 0) { float* ML = (float*)(ws + WS_ML) + pi * 2; ML[0] = mrun; ML[1] = lrun; }
        }
    }
    __syncthreads();
}
__device__ __forceinline__ void moba_combine(const Params& P, int lane, int wave, int bid, int G) {
    unsigned char* ws = P.ws;
    const bf16_t* PART = (const bf16_t*)(ws + WS_PART); const float* ML = (const float*)(ws + WS_ML); bf16_t* OA = (bf16_t*)(ws + WS_OA);
    const int gw = bid * 8 + wave, NGW = G * 8, hd = lane >> 3, dc = lane & 7;
    for (int tok = gw; tok < M; tok += NGW) {
        const int b = tok >> 13, q = tok & (SEQ - 1); const size_t base = (size_t)((b * 8 + hd) * 8192 + q) * 4;
        float ms[4], ls[4]; float mx = -1e30f;
#pragma unroll
        for (int s = 0; s < 4; ++s) { const f32x2_t ml = *(const f32x2_t*)(ML + (base + s) * 2); ms[s] = ml[0]; ls[s] = ml[1]; mx = fmaxf(mx, ml[1] > 0.f ? ml[0] : -1e30f); }
        float acc[16]; float wsum = 0.f;
#pragma unroll
        for (int j = 0; j < 16; ++j) acc[j] = 0.f;
#pragma unroll
        for (int s = 0; s < 4; ++s) {
            if (ls[s] > 0.f) { const float w = ls[s] * __builtin_amdgcn_exp2f(ms[s] - mx); wsum += w;
                const u32x4 a = *(const u32x4*)(PART + (base + s) * 128 + 16 * dc), c = *(const u32x4*)(PART + (base + s) * 128 + 16 * dc + 8);
                acc[0] += w * bflo(a.x); acc[1] += w * bfhi(a.x); acc[2] += w * bflo(a.y); acc[3] += w * bfhi(a.y); acc[4] += w * bflo(a.z); acc[5] += w * bfhi(a.z); acc[6] += w * bflo(a.w); acc[7] += w * bfhi(a.w);
                acc[8] += w * bflo(c.x); acc[9] += w * bfhi(c.x); acc[10] += w * bflo(c.y); acc[11] += w * bfhi(c.y); acc[12] += w * bflo(c.z); acc[13] += w * bfhi(c.z); acc[14] += w * bflo(c.w); acc[15] += w * bfhi(c.w); } }
        const float inv = 1.0f / wsum;
        u32x4 o0, o1;
        o0.x = cvtpk(acc[0] * inv, acc[1] * inv); o0.y = cvtpk(acc[2] * inv, acc[3] * inv); o0.z = cvtpk(acc[4] * inv, acc[5] * inv); o0.w = cvtpk(acc[6] * inv, acc[7] * inv);
        o1.x = cvtpk(acc[8] * inv, acc[9] * inv); o1.y = cvtpk(acc[10] * inv, acc[11] * inv); o1.z = cvtpk(acc[12] * inv, acc[13] * inv); o1.w = cvtpk(acc[14] * inv, acc[15] * inv);
        bf16_t* op = OA + (size_t)tok * 1024 + 128 * hd + 16 * dc;
        *(u32x4*)op = o0; *(u32x4*)(op + 8) = o1;
    }
}

__device__ __forceinline__ void p8_router(const Params& P, ldsp lds, int tid, int lane, int wave, int bid, int G) {
    unsigned char* ws = P.ws;
    LAS float* WR = (LAS float*)lds;
    for (int idx = tid; idx < 32768; idx += 512) { const int c = idx >> 5, e = idx & 31; WR[e * 1024 + c] = P.w_router[idx]; }
    LAS int* LH = (LAS int*)(lds + LH_OFF); LAS int* LBASE = (LAS int*)(lds + LBASE_OFF);
    if (tid < 32) LH[tid] = 0;
    __syncthreads();
    const float* X1 = (const float*)(ws + WS_X1); const float* CO = (const float*)(ws + WS_COEF); bf16_t* H = (bf16_t*)(ws + WS_H);
    const int gw = bid * 8 + wave, NGW = G * 8;
    int rec_e = 0, rec_r = 0, rec_m = -1; float rec_w = 0.f;
    int it = 0;
    for (int m = gw; m < M; m += NGW, ++it) {
        const int b = m >> 13;
        const f32x4* xr = (const f32x4*)(X1 + (size_t)m * 1024) + lane;
        f32x4 v[4]; float ss = 0.f;
#pragma unroll
        for (int j = 0; j < 4; ++j) { v[j] = xr[64 * j]; ss += (v[j][0] * v[j][0] + v[j][1] * v[j][1]) + (v[j][2] * v[j][2] + v[j][3] * v[j][3]); }
        const float rstd = 1.0f / sqrtf(wave_sum(ss) * (1.0f / 1024.0f) + RMS_EPS);
#pragma unroll
        for (int j = 0; j < 4; ++j) { const f32x4 a = *(const f32x4*)(CO + (b * 2 + 0) * 1024 + 4 * lane + 256 * j), bb = *(const f32x4*)(CO + (b * 2 + 1) * 1024 + 4 * lane + 256 * j);
            v[j] = v[j] * rstd * a + bb;
            u32x2 w; w.x = cvtpk(v[j][0], v[j][1]); w.y = cvtpk(v[j][2], v[j][3]);
            *(u32x2*)(H + (size_t)m * 1024 + 4 * lane + 256 * j) = w; }
        float lg[32];
#pragma unroll
        for (int e = 0; e < 32; ++e) { float a = 0.f;
#pragma unroll
            for (int j = 0; j < 4; ++j) { const f32x4 wv = *(const LAS f32x4*)(WR + e * 1024 + 4 * lane + 256 * j); a += (v[j][0] * wv[0] + v[j][1] * wv[1]) + (v[j][2] * wv[2] + v[j][3] * wv[3]); }
            lg[e] = wave_sum(a) + P.b_router[e]; }
        unsigned used = 0u; int te[4]; float tl[4];
#pragma unroll
        for (int k = 0; k < 4; ++k) { float best = -INFINITY; int be = 0;
#pragma unroll
            for (int e = 0; e < 32; ++e) { const bool ok = !((used >> e) & 1u); if (ok && lg[e] > best) { best = lg[e]; be = e; } }
            used |= 1u << be; te[k] = be; tl[k] = best; }
        const float e1 = __expf(tl[1] - tl[0]), e2 = __expf(tl[2] - tl[0]), e3 = __expf(tl[3] - tl[0]); const float isum = 1.0f / (1.0f + e1 + e2 + e3);
        const float tw[4] = {isum, e1 * isum, e2 * isum, e3 * isum};
        if ((lane >> 2) == it) { const int k = lane & 3; rec_e = k == 0 ? te[0] : k == 1 ? te[1] : k == 2 ? te[2] : te[3]; rec_w = k == 0 ? tw[0] : k == 1 ? tw[1] : k == 2 ? tw[2] : tw[3]; rec_m = m;
            rec_r = __hip_atomic_fetch_add(LH + rec_e, 1, __ATOMIC_RELAXED, __HIP_MEMORY_SCOPE_WORKGROUP); }
    }
    __syncthreads();
    if (tid < 32) LBASE[tid] = (int)atomicAdd((unsigned*)(ws + WS_CTL) + CW_CNT + 64 * tid, (unsigned)LH[tid]);
    __syncthreads();
    if (rec_m >= 0) { const int k = lane & 3; int* TOPE = (int*)(ws + WS_ROUTE); float* TOPW = (float*)(ws + WS_ROUTE + 256 * 1024); int* RANK = (int*)(ws + WS_ROUTE + 512 * 1024);
        TOPE[rec_m * 4 + k] = rec_e; TOPW[rec_m * 4 + k] = rec_w; RANK[rec_m * 4 + k] = LBASE[rec_e] + rec_r; }
}

__device__ __forceinline__ void p9_layout(const Params& P, ldsp lds, int tid) {
    LAS int* TEXP = (LAS int*)(lds + TEXP_OFF); LAS int* EST = (LAS int*)(lds + ESTART_OFF);
    if (tid == 0) { int acc = 0; const unsigned* cnt = (const unsigned*)(P.ws + WS_CTL) + CW_CNT;
        for (int e = 0; e < 32; ++e) { const int c = (int)__hip_atomic_load(cnt + 64 * e, __ATOMIC_RELAXED, __HIP_MEMORY_SCOPE_AGENT); const int pad = (c + 255) & ~255; EST[e] = acc;
            for (int t = acc >> 8; t < (acc + pad) >> 8; ++t) TEXP[t] = e; acc += pad; }
        EST[32] = acc; }
    __syncthreads();
}
__device__ __forceinline__ void p9_gather(const Params& P, ldsp lds, int tid, int lane, int wave, int bid, int G) {
    unsigned char* ws = P.ws;
    const LAS int* EST = (const LAS int*)(lds + ESTART_OFF);
    const int* TOPE = (const int*)(ws + WS_ROUTE); const int* RANK = (const int*)(ws + WS_ROUTE + 512 * 1024); int* POS = (int*)(ws + WS_ROUTE + 768 * 1024);
    const bf16_t* H = (const bf16_t*)(ws + WS_H); bf16_t* XP = (bf16_t*)(ws + WS_XP);
    const int gw = bid * 8 + wave, NGW = G * 8;
    for (int m = gw; m < M; m += NGW) {
        int pos = 0;
        if (lane < 4) { pos = EST[TOPE[m * 4 + lane]] + RANK[m * 4 + lane]; POS[m * 4 + lane] = pos; }
        const u32x4 a = *(const u32x4*)(H + (size_t)m * 1024 + 16 * lane), bq = *(const u32x4*)(H + (size_t)m * 1024 + 16 * lane + 8);
#pragma unroll
        for (int k = 0; k < 4; ++k) { const int pk = __shfl(pos, k); bf16_t* dp = XP + (size_t)pk * 1024 + 16 * lane; *(u32x4*)dp = a; *(u32x4*)(dp + 8) = bq; }
    }
}

__device__ __forceinline__ void p12_final(const Params& P, int lane, int wave, int bid, int G) {
    unsigned char* ws = P.ws;
    const float* X1 = (const float*)(ws + WS_X1); const float* MOD = (const float*)(ws + WS_MOD); const bf16_t* YS = (const bf16_t*)(ws + WS_YS);
    const float* TOPW = (const float*)(ws + WS_ROUTE + 256 * 1024); const int* POS = (const int*)(ws + WS_ROUTE + 768 * 1024);
    const int gw = bid * 8 + wave, NGW = G * 8;
    for (int m = gw; m < M; m += NGW) {
        const int b = m >> 13;
        int pos = 0; float wt = 0.f;
        if (lane < 4) { pos = POS[m * 4 + lane]; wt = TOPW[m * 4 + lane]; }
        const f32x4* xr = (const f32x4*)(X1 + (size_t)m * 1024) + lane;
        f32x4 v[4], acc[4];
#pragma unroll
        for (int j = 0; j < 4; ++j) { v[j] = xr[64 * j]; acc[j] = (f32x4){0.f, 0.f, 0.f, 0.f}; }
#pragma unroll
        for (int k = 0; k < 4; ++k) { const int pk = __shfl(pos, k); const float wk = __shfl(wt, k);
#pragma unroll
            for (int j = 0; j < 4; ++j) { const u32x2 y = *(const u32x2*)(YS + (size_t)pk * 1024 + 4 * lane + 256 * j);
                acc[j][0] += wk * bflo(y.x); acc[j][1] += wk * bfhi(y.x); acc[j][2] += wk * bflo(y.y); acc[j][3] += wk * bfhi(y.y); } }
        float ss = 0.f;
#pragma unroll
        for (int j = 0; j < 4; ++j) { const f32x4 g2 = *(const f32x4*)(MOD + b * 6144 + 5120 + 4 * lane + 256 * j); v[j] = v[j] + g2 * acc[j];
            ss += (v[j][0] * v[j][0] + v[j][1] * v[j][1]) + (v[j][2] * v[j][2] + v[j][3] * v[j][3]); }
        const float rstd = 1.0f / sqrtf(wave_sum(ss) * (1.0f / 1024.0f) + RMS_EPS);
#pragma unroll
        for (int j = 0; j < 4; ++j) { const f32x4 fw = *(const f32x4*)(P.final_norm_w + 4 * lane + 256 * j); *((f32x4*)(P.out + (size_t)m * 1024) + lane + 64 * j) = v[j] * rstd * fw; }
    }
}

#ifndef REPMASK
#define REPMASK 0
#endif
#define REPN(i) (((REPMASK >> (i)) & 1) + 1)
__global__ void __launch_bounds__(512, 2) mk_fwd(Params P) {
    extern __shared__ __attribute__((aligned(16))) unsigned char lds_raw[];
    ldsp lds = (ldsp)lds_raw;
    const int tid = threadIdx.x, lane = tid & 63, wave = __builtin_amdgcn_readfirstlane(tid >> 6);
    const int bid = blockIdx.x, G = gridDim.x;
    unsigned char* ws = P.ws;
    for (int u = tid; u < (LDS_BYTES - LDSCTL_OFF) / 4; u += 512) ((LAS unsigned*)(lds + LDSCTL_OFF))[u] = 0u;
    __syncthreads();
    volatile LAS unsigned* MISC = (volatile LAS unsigned*)(lds + MISC_OFF);
    XcdBarrier bar = xcd_barrier_post((unsigned*)(ws + WS_CTL) + CW_BAR, MISC + 8);

#if !defined(PHMASK) || ((PHMASK >> 0) & 1)
    for (int rep_ = 0; rep_ < REPN(0); ++rep_) {
    p0_prologue(P, lds, tid, lane, wave, bid, G);
    }
    xcd_barrier(bar);
#endif
#if !defined(PHMASK) || ((PHMASK >> 1) & 1)
    for (int rep_ = 0; rep_ < REPN(1); ++rep_) {
    p1_norm1(P, lds, tid, lane, wave, bid, G);
    }
    xcd_barrier(bar);
#endif
#if !defined(PHMASK) || ((PHMASK >> 2) & 1)
    {
        pg8::Gemm g{(const pg8::bf16_t*)(ws + WS_H), (const pg8::bf16_t*)(ws + WS_WIN), M, NMAIN, 1024}; pg8::StaticOrder S; S.init(M, NMAIN, G, bid, REPN(2));
        pg8::EpiInProj E{ws, P.b_merge};
        pg8::gemm_phase<pg8::EpiInProj, pg8::StaticOrder, true, true>(lds, g, S, E);
    }
    {
        pg8::Gemm g{(const pg8::bf16_t*)(ws + WS_WV), (const pg8::bf16_t*)(ws + WS_H), 1024, M, 1024}; pg8::StaticOrder S; S.init(1024, M, G, bid, REPN(2));
        pg8::EpiBf16<0> E{(pg8::bf16_t*)(ws + WS_VT), M, nullptr, 0, 0, 1.f};
        pg8::gemm_phase<pg8::EpiBf16<0>, pg8::StaticOrder, true, true>(lds, g, S, E);
    }
    xcd_barrier(bar);
#endif
#if !defined(PHMASK) || ((PHMASK >> 3) & 1)
    for (int rep_ = 0; rep_ < REPN(3); ++rep_) {
    for (int item = bid; item < 512; item += G) kmean_item(P, lds, item, tid);
    for (int u = bid; u < 256; u += G) gla_unit<false>(P, lds, u >> 5, u & 31, tid, lane, wave);
    }
    xcd_barrier(bar);
#endif
#if !defined(PHMASK) || ((PHMASK >> 4) & 1)
    for (int rep_ = 0; rep_ < REPN(4); ++rep_) {
    if (bid * 512 + tid < 131072) gla_scan(P, tid, bid);
    for (int u = bid; u < 512; u += G) moba_select_unit(P, lds, u >> 8, (u >> 5) & 7, u & 31, tid, lane, wave);
    }
    xcd_barrier(bar);
#endif
#if !defined(PHMASK) || ((PHMASK >> 5) & 1)
    {
        moba_item_table(P, lds, lane, wave);
        volatile LAS int* QI = (volatile LAS int*)(lds + QI_OFF);
        const int NATT = ((const LAS int*)(lds + IPFX_OFF))[512]; const int NG = 256 * REPN(13); const int total = NG + NATT * REPN(5);
        for (;;) {
            if (tid == 0) QI[0] = (int)atomicAdd((unsigned*)(ws + WS_CTL) + CW_QHEAD, 1u);
            __syncthreads();
            const int it = __builtin_amdgcn_readfirstlane(QI[0]);
            __syncthreads();
            if (it >= total) break;
            if (it < NG) gla_unit<true>(P, lds, (it & 255) >> 5, it & 31, tid, lane, wave);
            else moba_item(P, lds, (it - NG) % NATT, tid, wave);
        }
    }
    xcd_barrier(bar);
    moba_combine(P, lane, wave, bid, G);
    xcd_barrier(bar);
#endif
#if !defined(PHMASK) || ((PHMASK >> 6) & 1)
    {
        pg8::Gemm g{(const pg8::bf16_t*)(ws + WS_OA), (const pg8::bf16_t*)(ws + WS_WOA), M, 1024, 1024}; pg8::StaticOrder S; S.init(M, 1024, G, bid, REPN(6));
        pg8::EpiT1 E{(const bf16_t*)(ws + WS_GA), (float*)(ws + WS_T1)};
        pg8::gemm_phase<pg8::EpiT1, pg8::StaticOrder, true, true>(lds, g, S, E);
    }
    {
        pg8::Gemm g{(const pg8::bf16_t*)(ws + WS_OB), (const pg8::bf16_t*)(ws + WS_WOB), M, 1024, 1024}; pg8::StaticOrder S; S.init(M, 1024, G, bid, REPN(6));
        pg8::EpiMerge E{(const bf16_t*)(ws + WS_GB), (const float*)(ws + WS_T1), (bf16_t*)(ws + WS_MERGED)};
        pg8::gemm_phase<pg8::EpiMerge, pg8::StaticOrder, true, true>(lds, g, S, E);
    }
    xcd_barrier(bar);
#endif
#if !defined(PHMASK) || ((PHMASK >> 7) & 1)
    {
        pg8::Gemm g{(const pg8::bf16_t*)(ws + WS_MERGED), (const pg8::bf16_t*)(ws + WS_WOUT), M, 1024, 1024}; pg8::StaticOrder S; S.init(M, 1024, G, bid, REPN(7));
        pg8::EpiX1 E{P.x, (const float*)(ws + WS_MOD), (float*)(ws + WS_X1)};
        pg8::gemm_phase<pg8::EpiX1, pg8::StaticOrder, true, true>(lds, g, S, E);
    }
    xcd_barrier(bar);
#endif
#if !defined(PHMASK) || ((PHMASK >> 8) & 1)
    for (int rep_ = 0; rep_ < REPN(8); ++rep_) {
    p8_router(P, lds, tid, lane, wave, bid, G);
    }
    xcd_barrier(bar);
#endif
#if !defined(PHMASK) || ((PHMASK >> 9) & 1)
    for (int rep_ = 0; rep_ < REPN(9); ++rep_) {
    p9_layout(P, lds, tid);
    p9_gather(P, lds, tid, lane, wave, bid, G);
    }
    xcd_barrier(bar);
#endif
#if !defined(PHMASK) || ((PHMASK >> 10) & 1)
    {
        pg8::Gemm g{(const pg8::bf16_t*)(ws + WS_XP), (const pg8::bf16_t*)(ws + WS_WE1), PT_MAX * 256, 2048, 1024};
        pg8::GroupedOrder S{8, G, bid, (const LAS int*)(lds + TEXP_OFF), (const LAS int*)(lds + ESTART_OFF), (size_t)2048 * 1024 * 2, REPN(10)};
        pg8::EpiMoE1 E{P.b_exp_in, (bf16_t*)(ws + WS_ACT)};
        pg8::gemm_phase<pg8::EpiMoE1, pg8::GroupedOrder, true, true>(lds, g, S, E);
    }
    xcd_barrier(bar);
#endif
#if !defined(PHMASK) || ((PHMASK >> 11) & 1)
    {
        pg8::Gemm g{(const pg8::bf16_t*)(ws + WS_ACT), (const pg8::bf16_t*)(ws + WS_WE2), PT_MAX * 256, 1024, 1024};
        pg8::GroupedOrder S{4, G, bid, (const LAS int*)(lds + TEXP_OFF), (const LAS int*)(lds + ESTART_OFF), (size_t)1024 * 1024 * 2, REPN(11)};
        pg8::EpiMoE2 E{P.b_exp_out, (bf16_t*)(ws + WS_YS)};
        pg8::gemm_phase<pg8::EpiMoE2, pg8::GroupedOrder, true, true>(lds, g, S, E);
    }
    xcd_barrier(bar);
#endif
#if !defined(PHMASK) || ((PHMASK >> 12) & 1)
    for (int rep_ = 0; rep_ < REPN(12); ++rep_) {
    p12_final(P, lane, wave, bid, G);
    }
#endif
}

extern "C" void kernel_launch(void* const* d_in, const int* in_sizes, int n_in, void* d_out, int out_size, void* d_ws, size_t ws_size, hipStream_t stream) {
    static int grid = 0;
    if (grid == 0) {
        if (n_in != 21 || in_sizes[0] != M * D || out_size != M * D || ws_size < WS_END) { fprintf(stderr, "kernel_launch: unexpected shapes (n_in %d, in0 %d, out %d, ws %zu); nothing launched\n", n_in, n_in > 0 ? in_sizes[0] : -1, out_size, ws_size); grid = -1; return; }
        int dev = 0, cus = 0, per_cu = 0;
        if (hipGetDevice(&dev) != hipSuccess || hipDeviceGetAttribute(&cus, hipDeviceAttributeMultiprocessorCount, dev) != hipSuccess) { grid = -1; return; }
        if (hipFuncSetAttribute((const void*)mk_fwd, hipFuncAttributeMaxDynamicSharedMemorySize, LDS_BYTES) != hipSuccess) { fprintf(stderr, "kernel_launch: hipFuncSetAttribute failed\n"); grid = -1; return; }
        if (hipOccupancyMaxActiveBlocksPerMultiprocessor(&per_cu, (const void*)mk_fwd, 512, LDS_BYTES) != hipSuccess || per_cu < 1) { fprintf(stderr, "kernel_launch: occupancy query says %d workgroups per CU; nothing launched\n", per_cu); (void)hipGetLastError(); grid = -1; return; }
        grid = cus;
    }
    if (grid < 0) return;
    (void)hipMemsetAsync((char*)d_ws + WS_CTL, 0, CTL_ZERO_BYTES, stream);
    Params p{};
    const float** pp = (const float**)&p;
    for (int i = 0; i < 21; ++i) pp[i] = (const float*)d_in[i];
    p.out = (float*)d_out; p.ws = (unsigned char*)d_ws;
    void* args[] = {&p};
    hipError_t e = hipLaunchCooperativeKernel((const void*)mk_fwd, dim3(grid), dim3(512), args, LDS_BYTES, stream);
    if (e != hipSuccess) fprintf(stderr, "kernel_launch: cooperative launch failed: %s (grid %d)\n", hipGetErrorString(e), grid);
}
```

```cpp
#include <hip/hip_runtime.h>
#include <hip/hip_bf16.h>
#include <cstdio>
#include <cstdint>
#define LAS __attribute__((address_space(3)))
namespace pg8 {
#define PG8_LAS __attribute__((address_space(3)))
typedef unsigned short bf16_t;
typedef short bf16x8 __attribute__((ext_vector_type(8)));
typedef float f32x4 __attribute__((ext_vector_type(4)));
typedef unsigned u32x4 __attribute__((ext_vector_type(4)));
typedef int i32x4_ __attribute__((ext_vector_type(4)));
typedef int i32x8_ __attribute__((ext_vector_type(8)));
constexpr int BM = 256, BK = 64, HALF = 128, HTB = HALF * BK * 2  , STAGE_BYTES = 8 * HTB, NXCD = 8, WGM = 8;

__host__ __device__ __forceinline__ int lds_byte(int r, int c) { const int st = (r >> 4) * 2 + (c >> 5), rr = r & 15, cc = c & 31, ob = rr * 64 + cc * 2; return st * 1024 + (ob ^ (((ob >> 9) & 1) << 5)); }
__host__ __device__ __forceinline__ void stage_rc(int b, int& R, int& C) { const int st = b / 1024, sb = b % 1024, swz = sb ^ (((sb >> 9) & 1) << 5); R = (st >> 1) * 16 + swz / 64; C = (st & 1) * 32 + (swz % 64) / 2; }
__host__ __device__ __forceinline__ int perm32(int rho) { const int n = rho >> 4, i = rho & 15; return 8 * (i >> 2) + 4 * n + (i & 3); }

struct Unit { int pm, pn, e; };
struct Gemm { const bf16_t* A; const bf16_t* Bt; int M, N, K; int sa, sb; };

struct StaticOrder {
    int nM, nN, nwg, G, c, rep;
    __host__ __device__ void init(int M, int N, int G_, int c_, int rep_ = 1) { nM = M / BM; nN = N / BM; nwg = nM * nN; G = G_; c = c_; rep = rep_; }
    __host__ __device__ bool next(int i, Unit& u) const {
        long L = (long)i * G + c; if (L >= (long)nwg * rep) return false; if (L >= nwg) L -= nwg;
        int wgid = (int)L; { const int q = nwg / NXCD, r = nwg % NXCD, xcd = wgid % NXCD, off = wgid / NXCD; wgid = (xcd < r ? xcd * (q + 1) : r * (q + 1) + (xcd - r) * q) + off; }
        const int nig = WGM * nN, gid = wgid / nig, fm = gid * WGM, gsz = (nM - fm) < WGM ? (nM - fm) : WGM;
        u.pm = fm + ((wgid % nig) % gsz); u.pn = (wgid % nig) / gsz; u.e = 0; return true;
    }
    __device__ __forceinline__ const char* baseA(const Gemm& g, const Unit& u, size_t tstep) const { return (const char*)g.A + (size_t)u.pm * tstep; }
    __device__ __forceinline__ const char* baseB(const Gemm& g, const Unit& u, size_t tstep) const { return (const char*)g.Bt + (size_t)u.pn * tstep; }
    __device__ __forceinline__ void a_ready(const Unit&) const {}
    __device__ __forceinline__ void done(const Unit&) const {}
};

__device__ __forceinline__ unsigned cvt_pk_bf16(float lo, float hi) { unsigned r; asm volatile("v_cvt_pk_bf16_f32 %0, %1, %2" : "=v"(r) : "v"(lo), "v"(hi)); return r; }
typedef float f32x2 __attribute__((ext_vector_type(2)));
__device__ __forceinline__ f32x2 gelu_pk(f32x2 v) {
    const f32x2 av = __builtin_elementwise_abs(v), d = av * 0.2316418882f + 1.0f;
    f32x2 t; t.x = __builtin_amdgcn_rcpf(d.x); t.y = __builtin_amdgcn_rcpf(d.y);
    f32x2 q = t * 0.5307027145f + (-0.7265760135f); q = q * t + 0.7107068705f; q = q * t + (-0.142248368f); q = q * t + 0.127414796f; q = q * t;
    const f32x2 s = (v * v) * (-0.72134752044f);
    f32x2 e; e.x = __builtin_amdgcn_exp2f(s.x); e.y = __builtin_amdgcn_exp2f(s.y);
    const f32x2 m = v * (q * e), r = v - m;
    f32x2 o; o.x = v.x < 0.f ? m.x : r.x; o.y = v.y < 0.f ? m.y : r.y; return o;
}

template <int ACT  > struct EpiBf16 {
    static constexpr bool PERM = true, AFTER_DRAIN = false; static_assert(ACT == 0 || ACT == 1, "EpiBf16: ACT is 0 (none) or 1 (gelu_pk)");
    bf16_t* O; int ldc; const float* bias; int split_cols; size_t split_stride; float scale0;
    __device__ __forceinline__ void operator()(const f32x4 (&acc)[2][2][4][2], const Unit& u, int wr, int wc, int fr, int fq) const {
        const int row0 = u.pm * BM + wr * 64 + fr; int colt = u.pn * BM; bf16_t* base = O;
        float sc = 1.f; if (split_cols) { const int t = colt / split_cols; base += (size_t)t * split_stride; colt -= t * split_cols; if (t == 0) sc = scale0; }
        const int col0 = colt + wc * 32 + 8 * fq, bcol0 = u.pn * BM + wc * 32 + 8 * fq;
        f32x4 bv[2][2];
#pragma unroll
        for (int bj = 0; bj < 2; ++bj)
#pragma unroll
            for (int n = 0; n < 2; ++n) bv[bj][n] = bias ? *(const f32x4*)(bias + bcol0 + bj * HALF + 4 * n) : (f32x4){0.f, 0.f, 0.f, 0.f};
#pragma unroll
        for (int ai = 0; ai < 2; ++ai)
#pragma unroll
            for (int m = 0; m < 4; ++m) { bf16_t* rowp = base + (size_t)(row0 + ai * HALF + m * 16) * ldc + col0;
#pragma unroll
                for (int bj = 0; bj < 2; ++bj) { f32x4 v0 = acc[ai][bj][m][0] + bv[bj][0], v1 = acc[ai][bj][m][1] + bv[bj][1];
                    if (ACT == 1) { f32x2 a = gelu_pk((f32x2){v0[0], v0[1]}), b = gelu_pk((f32x2){v0[2], v0[3]}), c = gelu_pk((f32x2){v1[0], v1[1]}), d = gelu_pk((f32x2){v1[2], v1[3]});
                        v0 = (f32x4){a.x, a.y, b.x, b.y}; v1 = (f32x4){c.x, c.y, d.x, d.y}; }
                    v0 = v0 * sc; v1 = v1 * sc; u32x4 w; w.x = cvt_pk_bf16(v0[0], v0[1]); w.y = cvt_pk_bf16(v0[2], v0[3]); w.z = cvt_pk_bf16(v1[0], v1[1]); w.w = cvt_pk_bf16(v1[2], v1[3]);
                    *(u32x4*)(rowp + bj * HALF) = w; } }
    }
};

template <class Epi, class Sched, bool ALIGN_EPI = false, bool SP2 = false, bool FP8 = false>
__device__ __forceinline__ void gemm_phase(PG8_LAS unsigned char* lds, const Gemm g, const Sched& S, const Epi& E) {
    int tid_ = threadIdx.x; asm volatile("" : "+v"(tid_));
    const int tid = tid_, wid = __builtin_amdgcn_readfirstlane(tid >> 6), lane = tid & 63, wr = wid >> 2, wc = wid & 3, fr = lane & 15, fq = lane >> 4;
    const int K = g.K, nt = K / BK;
    unsigned voffA[2], voffB[2];
#pragma unroll
    for (int i = 0; i < 2; ++i) { int R, C; stage_rc(tid * 16 + i * 8192, R, C); const int Rb = Epi::PERM ? ((R & ~31) + perm32(R & 31)) : R;
        voffA[i] = (unsigned)(R * K + C) * 2u; voffB[i] = (unsigned)(Rb * K + C) * 2u; }
    const size_t kstep = (size_t)(BK * 2);
    const size_t hstep = (size_t)HALF * K * 2;
    const size_t tstep = 2 * hstep;
    const unsigned ldsw = (unsigned)wid * 1024u;
    const int aoff = lds_byte(wr * 64 + fr, fq * 8), boff = lds_byte(wc * 32 + fr, fq * 8);
#define PG8_SA(b, h) (((b) * 2 + (h)) * HTB)
#define PG8_SB(b, h) ((4 + (b) * 2 + (h)) * HTB)
#define PG8_STAGE(bufoff, gbase, voff) do { _Pragma("unroll") for (int _i = 0; _i < 2; ++_i) \
        __builtin_amdgcn_global_load_lds((const unsigned*)((const char*)(gbase) + (voff)[_i]), (PG8_LAS unsigned*)(lds + (bufoff) + ldsw + _i * 8192), 16, 0, 0); } while (0)
#define PG8_LDA(dst, b, h) do { _Pragma("unroll") for (int m = 0; m < 4; ++m) _Pragma("unroll") for (int k = 0; k < 2; ++k) dst[m][k] = *(const PG8_LAS bf16x8*)(lds + PG8_SA(b, h) + aoff + m * 2048 + k * 1024); } while (0)
#define PG8_LDB(dst, b, h) do { _Pragma("unroll") for (int n = 0; n < 2; ++n) _Pragma("unroll") for (int k = 0; k < 2; ++k) dst[n][k] = *(const PG8_LAS bf16x8*)(lds + PG8_SB(b, h) + boff + n * 2048 + k * 1024); } while (0)
#define PG8_CAT8(x, y) __builtin_shufflevector(__builtin_bit_cast(i32x4_, (x)), __builtin_bit_cast(i32x4_, (y)), 0, 1, 2, 3, 4, 5, 6, 7)
#define PG8_MMA(ai, bj, At, Bt) do { __builtin_amdgcn_s_setprio(1); _Pragma("unroll") for (int m = 0; m < 4; ++m) _Pragma("unroll") for (int n = 0; n < 2; ++n) { \
        if constexpr (FP8) { const i32x8_ b8_ = PG8_CAT8(Bt[n][0], Bt[n][1]), a8_ = PG8_CAT8(At[m][0], At[m][1]); \
            asm volatile("s_nop 1\n\tv_mfma_scale_f32_16x16x128_f8f6f4 %0, %1, %2, %0, %3, %4 op_sel_hi:[0,0,0]" : "+v"(acc[ai][bj][m][n]) : "v"(b8_), "v"(a8_), "v"(g.sb), "v"(g.sa)); } \
        else { _Pragma("unroll") for (int k = 0; k < 2; ++k) acc[ai][bj][m][n] = __builtin_amdgcn_mfma_f32_16x16x32_bf16(Bt[n][k], At[m][k], acc[ai][bj][m][n], 0, 0, 0); } } __builtin_amdgcn_s_setprio(0); } while (0)
#define PG8_WAIT_V(n) asm volatile("s_waitcnt vmcnt(" #n ")" ::: "memory")
#define PG8_WAIT_L(n) asm volatile("s_waitcnt lgkmcnt(" #n ")" ::: "memory")
#define PG8_BAR __builtin_amdgcn_s_barrier()
#define PG8_SCHED __builtin_amdgcn_sched_barrier(0)
    Unit cur, nxt; int ui = 0;
    if (!S.next(0, cur)) return;
    f32x4 acc[2][2][4][2];
#pragma unroll
    for (int a = 0; a < 2; ++a)
#pragma unroll
        for (int b = 0; b < 2; ++b)
#pragma unroll
            for (int m = 0; m < 4; ++m)
#pragma unroll
                for (int n = 0; n < 2; ++n) acc[a][b][m][n] = (f32x4){0.f, 0.f, 0.f, 0.f};
    bf16x8 At[4][2], B0[2][2], B1[2][2];
    const char* cA = S.baseA(g, cur, tstep); const char* cB = S.baseB(g, cur, tstep);
    S.a_ready(cur);
    if constexpr (SP2) {
        PG8_STAGE(PG8_SB(0, 0), cB, voffB); PG8_STAGE(PG8_SB(0, 1), cB + hstep, voffB); PG8_STAGE(PG8_SA(0, 0), cA, voffA); PG8_STAGE(PG8_SA(0, 1), cA + hstep, voffA);
        if (wr == 1) PG8_BAR;
        PG8_WAIT_V(2); PG8_BAR;
        PG8_STAGE(PG8_SB(1, 0), cB + kstep, voffB); PG8_STAGE(PG8_SA(1, 0), cA + kstep, voffA); PG8_STAGE(PG8_SB(1, 1), cB + hstep + kstep, voffB);
        PG8_WAIT_V(6); PG8_BAR;
    } else {
        PG8_STAGE(PG8_SB(0, 0), cB, voffB); PG8_STAGE(PG8_SA(0, 0), cA, voffA); PG8_STAGE(PG8_SB(0, 1), cB + hstep, voffB); PG8_STAGE(PG8_SA(0, 1), cA + hstep, voffA);
        if (wr == 1) PG8_BAR;
        PG8_WAIT_V(4); PG8_BAR;
        PG8_STAGE(PG8_SB(1, 0), cB + kstep, voffB); PG8_STAGE(PG8_SA(1, 0), cA + kstep, voffA); PG8_STAGE(PG8_SB(1, 1), cB + hstep + kstep, voffB);
        PG8_WAIT_V(6); PG8_BAR;
    }
    for (;;) {
        const bool has_next = S.next(ui + 1, nxt);
        const char* nA = has_next ? S.baseA(g, nxt, tstep) : cA; const char* nB = has_next ? S.baseB(g, nxt, tstep) : cB;
        for (int t = 0; t < nt; t += 2) {
            const bool last = (t == nt - 2);
            const char* a1 = cA + (size_t)(t + 1) * kstep;
            const char* a2 = last ? nA : cA + (size_t)(t + 2) * kstep; const char* b2 = last ? nB : cB + (size_t)(t + 2) * kstep;
            const char* a3 = a2 + kstep; const char* b3 = b2 + kstep;
            if (last && has_next) S.a_ready(nxt);
            if constexpr (SP2) {
            PG8_LDB(B0, 0, 0); PG8_LDB(B1, 0, 1); PG8_SCHED; PG8_LDA(At, 0, 0); PG8_STAGE(PG8_SA(1, 1), a1 + hstep, voffA);
            PG8_WAIT_V(8); PG8_WAIT_L(0); PG8_BAR; PG8_MMA(0, 0, At, B0); PG8_MMA(0, 1, At, B1); PG8_BAR; PG8_SCHED;
            PG8_LDA(At, 0, 1); PG8_STAGE(PG8_SB(0, 0), b2, voffB); PG8_STAGE(PG8_SB(0, 1), b2 + hstep, voffB); PG8_STAGE(PG8_SA(0, 0), a2, voffA);
            PG8_WAIT_V(8); PG8_WAIT_L(0); PG8_BAR; PG8_MMA(1, 0, At, B0); PG8_MMA(1, 1, At, B1); PG8_BAR; PG8_SCHED;
            PG8_LDB(B0, 1, 0); PG8_LDB(B1, 1, 1); PG8_SCHED; PG8_LDA(At, 1, 0); PG8_STAGE(PG8_SA(0, 1), a2 + hstep, voffA);
            PG8_WAIT_V(8); PG8_WAIT_L(0); PG8_BAR; PG8_MMA(0, 0, At, B0); PG8_MMA(0, 1, At, B1); PG8_BAR; PG8_SCHED;
            PG8_LDA(At, 1, 1); PG8_STAGE(PG8_SB(1, 0), b3, voffB); PG8_STAGE(PG8_SB(1, 1), b3 + hstep, voffB); PG8_STAGE(PG8_SA(1, 0), a3, voffA);
            PG8_WAIT_V(8); PG8_WAIT_L(0); PG8_BAR; PG8_MMA(1, 0, At, B0); PG8_MMA(1, 1, At, B1); PG8_BAR; PG8_SCHED;
            } else {
            PG8_LDB(B0, 0, 0); PG8_SCHED; PG8_LDA(At, 0, 0); PG8_STAGE(PG8_SA(1, 1), a1 + hstep, voffA);
            PG8_WAIT_L(8); PG8_BAR; PG8_WAIT_L(0); PG8_MMA(0, 0, At, B0); PG8_BAR; PG8_SCHED;
            PG8_LDB(B1, 0, 1); PG8_STAGE(PG8_SB(0, 0), b2, voffB);
            PG8_BAR; PG8_WAIT_L(0); PG8_MMA(0, 1, At, B1); PG8_BAR;
            PG8_LDA(At, 0, 1); PG8_STAGE(PG8_SA(0, 0), a2, voffA);
            PG8_BAR; PG8_WAIT_L(0); PG8_MMA(1, 0, At, B0); PG8_BAR; PG8_SCHED;
            PG8_STAGE(PG8_SB(0, 1), b2 + hstep, voffB);
            PG8_WAIT_V(6); PG8_BAR; PG8_MMA(1, 1, At, B1); PG8_BAR;
            PG8_LDB(B0, 1, 0); PG8_SCHED; PG8_LDA(At, 1, 0); PG8_STAGE(PG8_SA(0, 1), a2 + hstep, voffA);
            PG8_WAIT_L(8); PG8_BAR; PG8_WAIT_L(0); PG8_MMA(0, 0, At, B0); PG8_BAR; PG8_SCHED;
            PG8_LDB(B1, 1, 1); PG8_STAGE(PG8_SB(1, 0), b3, voffB);
            PG8_BAR; PG8_WAIT_L(0); PG8_MMA(0, 1, At, B1); PG8_BAR;
            PG8_LDA(At, 1, 1); PG8_STAGE(PG8_SA(1, 0), a3, voffA);
            PG8_BAR; PG8_WAIT_L(0); PG8_MMA(1, 0, At, B0); PG8_BAR; PG8_SCHED;
            PG8_STAGE(PG8_SB(1, 1), b3 + hstep, voffB);
            PG8_WAIT_V(6); PG8_BAR; PG8_MMA(1, 1, At, B1); PG8_BAR;
            }
        }
        if constexpr (ALIGN_EPI) { if (wr == 0) PG8_BAR; }
        if constexpr (FP8) asm volatile("s_nop 15\n\ts_nop 7" ::: "memory");
        if constexpr (!Epi::AFTER_DRAIN) { E(acc, cur, wr, wc, fr, fq); S.done(cur); }
        if (!has_next) break;
#pragma unroll
        for (int a = 0; a < 2; ++a)
#pragma unroll
            for (int b = 0; b < 2; ++b)
#pragma unroll
                for (int m = 0; m < 4; ++m)
#pragma unroll
                    for (int n = 0; n < 2; ++n) acc[a][b][m][n] = (f32x4){0.f, 0.f, 0.f, 0.f};
        cur = nxt; cA = nA; cB = nB; ++ui;
        if constexpr (ALIGN_EPI) { if (wr == 1) PG8_BAR; }
    }
    PG8_WAIT_V(0);
    if constexpr (!ALIGN_EPI) { if (wr == 0) PG8_BAR; }
    PG8_BAR;
    if constexpr (Epi::AFTER_DRAIN) { E.fused(acc, cur, wr, wc, fr, fq, lds, wid, lane); S.done(cur); }
#undef PG8_SA
#undef PG8_SB
#undef PG8_STAGE
#undef PG8_LDA
#undef PG8_LDB
#undef PG8_MMA
#undef PG8_CAT8
#undef PG8_WAIT_V
#undef PG8_WAIT_L
#undef PG8_BAR
#undef PG8_SCHED
}
}
#define XB_TMO      128
#define XB_XCNT(j)  (256  + 64 * (j))
#define XB_XSUB(j)  (1280 + 64 * (j))
#define XB_XGEN(j)  (2304 + 64 * (j))
#define XB_TOP      3328
#define XB_TOPGEN   3392
#define XCD_BAR_WORDS 3456
#define XB_SPIN_CAP (1u << 18)

__device__ __forceinline__ unsigned xb_ld(unsigned* p)              { return __hip_atomic_load(p, __ATOMIC_RELAXED, __HIP_MEMORY_SCOPE_AGENT); }
__device__ __forceinline__ unsigned xb_add(unsigned* p, unsigned v) { return __hip_atomic_fetch_add(p, v, __ATOMIC_RELAXED, __HIP_MEMORY_SCOPE_AGENT); }
__device__ __forceinline__ unsigned xb_xcc_id() { return (unsigned)__builtin_amdgcn_s_getreg((3 << 11) | 20) & 0xFu; }
#define XB_SPIN(cond, bar) do { unsigned _sp = 0; while (cond) { __builtin_amdgcn_s_sleep(1); \
    if ((++_sp & 255u) == 0u) { if (xb_ld(&(bar)[XB_TMO])) break; if (_sp > XB_SPIN_CAP) { atomicAdd(&(bar)[XB_TMO], 1u); break; } } } } while (0)

struct XcdBarrier {
    unsigned* bar; unsigned x;
    volatile LAS unsigned* st;
};

__device__ __forceinline__ XcdBarrier xcd_barrier_post(unsigned* bar, volatile LAS unsigned* st) {
    XcdBarrier b; b.bar = bar; b.x = xb_xcc_id(); b.st = st;
    if (threadIdx.x == 0) (void)xb_add(&bar[XB_XCNT(b.x)], 1u);
    return b;
}
__device__ __forceinline__ void xcd_barrier_complete(unsigned* bar, unsigned x, unsigned& nloc, unsigned& nx) {
    const unsigned G = gridDim.x * gridDim.y * gridDim.z;
    unsigned sum, cnt, mine, sp = 0u;
    for (;;) {
        sum = 0u; cnt = 0u; mine = 0u;
#pragma unroll
        for (unsigned j = 0; j < 16; ++j) { const unsigned c = xb_ld(&bar[XB_XCNT(j)]); sum += c; cnt += (c > 0u) ? 1u : 0u; mine = (j == x) ? c : mine; }
        if (sum == G) break;
        __builtin_amdgcn_s_sleep(1);
        if ((++sp & 255u) == 0u) { if (xb_ld(&bar[XB_TMO])) break; if (sp > XB_SPIN_CAP) { atomicAdd(&bar[XB_TMO], 1u); break; } }
    }
    nloc = mine > 0u ? mine : 1u; nx = cnt > 0u ? cnt : 1u;
}

__device__ __forceinline__ void xcd_barrier(const XcdBarrier& b) {
    asm volatile("s_waitcnt vmcnt(0)" ::: "memory");
    __syncthreads();
    if (threadIdx.x == 0) {
        unsigned* bar = b.bar;
        __builtin_amdgcn_s_waitcnt(0);
        unsigned nloc = b.st[0], nx = b.st[1];
        if (nloc == 0u) { xcd_barrier_complete(bar, b.x, nloc, nx); b.st[0] = nloc; b.st[1] = nx; }
        const unsigned old = xb_add(&bar[XB_XSUB(b.x)], 1u);
        const unsigned gen = old / nloc;
        if (old + 1u == (gen + 1u) * nloc) {
            __builtin_amdgcn_fence(__ATOMIC_RELEASE, "agent");
            asm volatile("s_waitcnt vmcnt(0)" ::: "memory");
            const unsigned og = xb_add(&bar[XB_TOP], 1u);
            const unsigned tg = og / nx;
            if (og + 1u == (tg + 1u) * nx) xb_add(&bar[XB_TOPGEN], 1u);
            else XB_SPIN(xb_ld(&bar[XB_TOPGEN]) == tg, bar);
            __builtin_amdgcn_fence(__ATOMIC_ACQUIRE, "agent");
            xb_add(&bar[XB_XGEN(b.x)], 1u);
            asm volatile("s_waitcnt vmcnt(0)" ::: "memory");
        } else {
            XB_SPIN(xb_ld(&bar[XB_XGEN(b.x)]) == gen, bar);
            __builtin_amdgcn_fence(__ATOMIC_ACQUIRE, "agent");
            asm volatile("s_waitcnt vmcnt(0)" ::: "memory");
        }
    }
    __syncthreads();
}

typedef LAS unsigned char* ldsp;
typedef unsigned short bf16_t;
typedef short bf16x8 __attribute__((ext_vector_type(8)));
typedef short s16x4 __attribute__((ext_vector_type(4)));
typedef float f32x4 __attribute__((ext_vector_type(4)));
typedef float f32x16 __attribute__((ext_vector_type(16)));
typedef unsigned u32x4 __attribute__((ext_vector_type(4)));
typedef unsigned u32x2 __attribute__((ext_vector_type(2)));
typedef float f32x2_t __attribute__((ext_vector_type(2)));
typedef __bf16 bf16x2_t __attribute__((ext_vector_type(2)));

constexpr int NB = 2, SEQ = 8192, M = NB * SEQ, D = 1024;
constexpr int NIN = 8208, NMAIN = 7168, NEXP = 32;
constexpr int PT_MAX = 288;
constexpr float RMS_EPS = 1e-5f;
constexpr float QK_SCALE = 0.08838834764831845f;
constexpr float C2 = QK_SCALE * 1.4426950408889634f;
constexpr float H2_SCALE = 8.0f, ACT_SCALE = 4.0f, WE_SCALE = 64.0f;
constexpr int SC_H2 = 0x7c7c7c7c, SC_ACT = 0x7d7d7d7d, SC_WE = 0x79797979;

constexpr size_t MiB = 1u << 20;
constexpr size_t WS_CTL = 0, CTL_ZERO_BYTES = 1 * MiB;
constexpr size_t WS_MODP = 1 * MiB;
constexpr size_t WS_MOD = 1 * MiB + 832 * 1024;
constexpr size_t WS_ROPE = 2 * MiB;
constexpr size_t WS_KM = 3 * MiB;
constexpr size_t WS_COEF = 3 * MiB + 512 * 1024;
constexpr size_t WS_DG = 3 * MiB + 640 * 1024;
constexpr size_t WS_ROUTE = 4 * MiB;
constexpr size_t WS_GLOW = 5 * MiB;
constexpr size_t WS_WIN = 8 * MiB, WS_WV = 22 * MiB, WS_WOA = 24 * MiB, WS_WOB = 26 * MiB, WS_WOUT = 28 * MiB;
constexpr size_t WS_WE1 = 32 * MiB, WS_WE2 = 160 * MiB, WS_H = 224 * MiB;
constexpr size_t WS_MQ = 256 * MiB, WS_MK = 288 * MiB, WS_VT = 320 * MiB, WS_GQ = 352 * MiB, WS_GK = 368 * MiB, WS_GV = 384 * MiB, WS_GR = 416 * MiB, WS_GA = 448 * MiB, WS_GB = 480 * MiB;
constexpr size_t WS_OA = 512 * MiB, WS_OB = 544 * MiB, WS_TG = 576 * MiB, WS_GS = 608 * MiB, WS_T1 = 640 * MiB, WS_MERGED = 704 * MiB, WS_X1 = 736 * MiB;
constexpr size_t WS_XP = 256 * MiB, WS_ACT = 400 * MiB, WS_YS = 544 * MiB, WS_END = 800 * MiB;
constexpr int CW_BAR = 4096, CW_CNT = 16384;

constexpr int LDS_BYTES = 163840, LDSCTL_OFF = 157696;
constexpr int MISC_OFF = LDSCTL_OFF;
constexpr int TEXP_OFF = LDSCTL_OFF + 128;
constexpr int ESTART_OFF = TEXP_OFF + 288 * 4;
constexpr int LH_OFF = ESTART_OFF + 40 * 4;
constexpr int LBASE_OFF = LH_OFF + 128;
constexpr int ALIST_OFF = LBASE_OFF + 128;
constexpr int QI_OFF = ALIST_OFF + 160;
constexpr int IPFX_OFF = QI_OFF + 16;
static_assert(IPFX_OFF + 516 * 4 <= LDS_BYTES, "LDS ctl map");

struct Params {
    const float *x, *c, *w_ada, *b_ada, *norm1_w, *w_in, *gla_gate_w, *gla_gate_b, *gla_norm_w, *w_o_moba, *w_o_gla, *b_merge, *w_out, *norm2_w, *w_router, *b_router, *w_exp_in, *b_exp_in, *w_exp_out, *b_exp_out, *final_norm_w;
    float* out; unsigned char* ws;
};

__device__ __forceinline__ unsigned cvtpk(float lo, float hi) { f32x2_t v = {lo, hi}; bf16x2_t b = __builtin_convertvector(v, bf16x2_t); return __builtin_bit_cast(unsigned, b); }
__device__ __forceinline__ unsigned f2bf(float f) { return cvtpk(f, 0.f) & 0xffffu; }
__device__ __forceinline__ float bf2f(unsigned b) { return __uint_as_float(b << 16); }
__device__ __forceinline__ float bflo(unsigned w) { return __uint_as_float(w << 16); }
__device__ __forceinline__ float bfhi(unsigned w) { return __uint_as_float(w & 0xffff0000u); }
__device__ __forceinline__ int crow(int reg, int h) { return (reg & 3) + 8 * (reg >> 2) + 4 * h; }
__device__ __forceinline__ float wave_sum(float v) {
#pragma unroll
    for (int o = 1; o < 64; o <<= 1) v += __shfl_xor(v, o);
    return v;
}
__device__ __forceinline__ float sigmoidf_(float z) { return 1.0f / (1.0f + __expf(-z)); }
#define MFMA32(a, b, c) __builtin_amdgcn_mfma_f32_32x32x16_bf16((a), (b), (c), 0, 0, 0)
template <int S> __device__ __forceinline__ bf16x8 pack8(const f32x16& x) {
    u32x4 p; p.x = cvtpk(x[8 * S + 0], x[8 * S + 1]); p.y = cvtpk(x[8 * S + 2], x[8 * S + 3]); p.z = cvtpk(x[8 * S + 4], x[8 * S + 5]); p.w = cvtpk(x[8 * S + 6], x[8 * S + 7]);
    return __builtin_bit_cast(bf16x8, p);
}
__device__ __forceinline__ bf16x8 cat44(s16x4 lo, s16x4 hi) { return __builtin_shufflevector(lo, hi, 0, 1, 2, 3, 4, 5, 6, 7); }

namespace pg8 {
struct EpiInProj {
    static constexpr bool PERM = true, AFTER_DRAIN = false;
    unsigned char* ws; const float* b_merge;
    __device__ __forceinline__ void operator()(const f32x4 (&acc)[2][2][4][2], const Unit& u, int wr, int wc, int fr, int fq) const {
        const int pn = u.pn; const int row0 = u.pm * BM + wr * 64 + fr; const int cl0 = wc * 32 + 8 * fq;
        bf16_t* dst; int ld = 1024, colt; int mode;
        float osc = 1.f; const float* bias = nullptr;
        if (pn < 4) { dst = (bf16_t*)(ws + WS_MQ); colt = pn * 256; mode = 0; osc = C2; }
        else if (pn < 8) { dst = (bf16_t*)(ws + WS_MK); colt = (pn - 4) * 256; mode = 0; }
        else if (pn < 10) { dst = (bf16_t*)(ws + WS_GQ); ld = 512; colt = (pn - 8) * 256; mode = 1; osc = QK_SCALE; }
        else if (pn < 12) { dst = (bf16_t*)(ws + WS_GK); ld = 512; colt = (pn - 10) * 256; mode = 2; }
        else if (pn < 16) { dst = (bf16_t*)(ws + WS_GV); colt = (pn - 12) * 256; mode = 2; }
        else if (pn < 20) { dst = (bf16_t*)(ws + WS_GR); colt = (pn - 16) * 256; mode = 3; }
        else if (pn < 24) { dst = (bf16_t*)(ws + WS_GA); colt = (pn - 20) * 256; mode = 4; bias = b_merge; }
        else { dst = (bf16_t*)(ws + WS_GB); colt = (pn - 24) * 256; mode = 4; bias = b_merge + 1024; }
        const float* rc = (const float*)(ws + WS_ROPE); const float* rs = rc + SEQ * 16;
        f32x4 bv[2][2];
#pragma unroll
        for (int bj = 0; bj < 2; ++bj)
#pragma unroll
            for (int n = 0; n < 2; ++n) bv[bj][n] = (mode == 4) ? *(const f32x4*)(bias + colt + bj * HALF + cl0 + 4 * n) : (f32x4){0.f, 0.f, 0.f, 0.f};
#pragma unroll
        for (int ai = 0; ai < 2; ++ai)
#pragma unroll
            for (int m = 0; m < 4; ++m) {
                const int row = row0 + ai * HALF + m * 16;
                f32x4 cs0 = {1.f, 1.f, 1.f, 1.f}, cs1 = cs0, sn0 = {0.f, 0.f, 0.f, 0.f}, sn1 = sn0;
                const bool rope = (mode == 0) && (wc == 0);
                if (rope) { const int pos = row & (SEQ - 1); const float* pc = rc + pos * 16 + 8 * (fq & 1); const float* ps = rs + pos * 16 + 8 * (fq & 1);
                    cs0 = *(const f32x4*)pc; cs1 = *(const f32x4*)(pc + 4); sn0 = *(const f32x4*)ps; sn1 = *(const f32x4*)(ps + 4);
                    if (fq < 2) { sn0 = -sn0; sn1 = -sn1; } }
                bf16_t* rowp = dst + (size_t)row * ld + colt + cl0;
#pragma unroll
                for (int bj = 0; bj < 2; ++bj) {
                    f32x4 v0 = acc[ai][bj][m][0], v1 = acc[ai][bj][m][1];
                    if (rope) {
                        f32x4 p0, p1;
#pragma unroll
                        for (int i = 0; i < 4; ++i) { p0[i] = __shfl_xor(v0[i], 32); p1[i] = __shfl_xor(v1[i], 32); }
                        v0 = v0 * cs0 + p0 * sn0; v1 = v1 * cs1 + p1 * sn1;
                    }
                    if (mode <= 1) { v0 = v0 * osc; v1 = v1 * osc; }
                    if (mode == 3) {
#pragma unroll
                        for (int i = 0; i < 4; ++i) { v0[i] = v0[i] * sigmoidf_(v0[i]); v1[i] = v1[i] * sigmoidf_(v1[i]); } }
                    if (mode == 4) { v0 = v0 + bv[bj][0]; v1 = v1 + bv[bj][1];
#pragma unroll
                        for (int i = 0; i < 4; ++i) { v0[i] = sigmoidf_(v0[i]); v1[i] = sigmoidf_(v1[i]); } }
                    u32x4 w; w.x = cvtpk(v0[0], v0[1]); w.y = cvtpk(v0[2], v0[3]); w.z = cvtpk(v1[0], v1[1]); w.w = cvtpk(v1[2], v1[3]);
                    *(u32x4*)(rowp + bj * HALF) = w;
                }
            }
    }
};
struct EpiT1 {
    static constexpr bool PERM = true, AFTER_DRAIN = false;
    const bf16_t* GA; float* T1;
    __device__ __forceinline__ void operator()(const f32x4 (&acc)[2][2][4][2], const Unit& u, int wr, int wc, int fr, int fq) const {
        const int row0 = u.pm * BM + wr * 64 + fr, col0 = u.pn * BM + wc * 32 + 8 * fq;
#pragma unroll
        for (int ai = 0; ai < 2; ++ai)
#pragma unroll
            for (int m = 0; m < 4; ++m) { const size_t off = (size_t)(row0 + ai * HALF + m * 16) * 1024 + col0;
#pragma unroll
                for (int bj = 0; bj < 2; ++bj) { const u32x4 g = *(const u32x4*)(GA + off + bj * HALF);
                    f32x4 v0 = acc[ai][bj][m][0], v1 = acc[ai][bj][m][1];
                    v0[0] *= bflo(g.x); v0[1] *= bfhi(g.x); v0[2] *= bflo(g.y); v0[3] *= bfhi(g.y); v1[0] *= bflo(g.z); v1[1] *= bfhi(g.z); v1[2] *= bflo(g.w); v1[3] *= bfhi(g.w);
                    *(f32x4*)(T1 + off + bj * HALF) = v0; *(f32x4*)(T1 + off + bj * HALF + 4) = v1; } }
    }
};
struct EpiMerge {
    static constexpr bool PERM = true, AFTER_DRAIN = false;
    const bf16_t* GB; const float* T1; bf16_t* O;
    __device__ __forceinline__ void operator()(const f32x4 (&acc)[2][2][4][2], const Unit& u, int wr, int wc, int fr, int fq) const {
        const int row0 = u.pm * BM + wr * 64 + fr, col0 = u.pn * BM + wc * 32 + 8 * fq;
#pragma unroll
        for (int ai = 0; ai < 2; ++ai)
#pragma unroll
            for (int m = 0; m < 4; ++m) { const size_t off = (size_t)(row0 + ai * HALF + m * 16) * 1024 + col0;
#pragma unroll
                for (int bj = 0; bj < 2; ++bj) { const u32x4 g = *(const u32x4*)(GB + off + bj * HALF);
                    const f32x4 t0 = *(const f32x4*)(T1 + off + bj * HALF), t1 = *(const f32x4*)(T1 + off + bj * HALF + 4);
                    f32x4 v0 = acc[ai][bj][m][0], v1 = acc[ai][bj][m][1];
                    v0[0] = t0[0] + v0[0] * bflo(g.x); v0[1] = t0[1] + v0[1] * bfhi(g.x); v0[2] = t0[2] + v0[2] * bflo(g.y); v0[3] = t0[3] + v0[3] * bfhi(g.y);
                    v1[0] = t1[0] + v1[0] * bflo(g.z); v1[1] = t1[1] + v1[1] * bfhi(g.z); v1[2] = t1[2] + v1[2] * bflo(g.w); v1[3] = t1[3] + v1[3] * bfhi(g.w);
                    u32x4 w; w.x = cvtpk(v0[0], v0[1]); w.y = cvtpk(v0[2], v0[3]); w.z = cvtpk(v1[0], v1[1]); w.w = cvtpk(v1[2], v1[3]);
                    *(u32x4*)(O + off + bj * HALF) = w; } }
    }
};
struct EpiX1 {
    static constexpr bool PERM = false, AFTER_DRAIN = false;
    const float* x; const float* mod; float* X1;
    __device__ __forceinline__ void operator()(const f32x4 (&acc)[2][2][4][2], const Unit& u, int wr, int wc, int fr, int fq) const {
        const int row0 = u.pm * BM + wr * 64 + fr, col0 = u.pn * BM + wc * 32 + 4 * fq;
        const float* g1 = mod + ((u.pm * BM) >> 13) * 6144 + 2048;
        f32x4 gv[2][2];
#pragma unroll
        for (int bj = 0; bj < 2; ++bj)
#pragma unroll
            for (int n = 0; n < 2; ++n) gv[bj][n] = *(const f32x4*)(g1 + col0 + bj * HALF + n * 16);
#pragma unroll
        for (int ai = 0; ai < 2; ++ai)
#pragma unroll
            for (int m = 0; m < 4; ++m) { const size_t off = (size_t)(row0 + ai * HALF + m * 16) * 1024 + col0;
#pragma unroll
                for (int bj = 0; bj < 2; ++bj)
#pragma unroll
                    for (int n = 0; n < 2; ++n) { const f32x4 xv = *(const f32x4*)(x + off + bj * HALF + n * 16);
                        *(f32x4*)(X1 + off + bj * HALF + n * 16) = xv + gv[bj][n] * acc[ai][bj][m][n]; } }
    }
};
struct EpiMoE1 {
    static constexpr bool PERM = true, AFTER_DRAIN = false;
    const float* b1; unsigned char* ACT;
    __device__ __forceinline__ void operator()(const f32x4 (&acc)[2][2][4][2], const Unit& u, int wr, int wc, int fr, int fq) const {
        const int row0 = u.pm * BM + wr * 64 + fr, col0 = u.pn * BM + wc * 32 + 8 * fq;
        const float* bp = b1 + (size_t)u.e * 2048 + col0;
        f32x4 bv[2][2];
#pragma unroll
        for (int bj = 0; bj < 2; ++bj)
#pragma unroll
            for (int n = 0; n < 2; ++n) bv[bj][n] = *(const f32x4*)(bp + bj * HALF + 4 * n);
#pragma unroll
        for (int ai = 0; ai < 2; ++ai)
#pragma unroll
            for (int m = 0; m < 4; ++m) { unsigned char* rowp = ACT + (size_t)(row0 + ai * HALF + m * 16) * 1024 + (col0 >> 1);
#pragma unroll
                for (int bj = 0; bj < 2; ++bj) { const f32x4 v0 = acc[ai][bj][m][0] + bv[bj][0], v1 = acc[ai][bj][m][1] + bv[bj][1];
                    float o[4];
#pragma unroll
                    for (int q = 0; q < 4; ++q) { const float gl = q < 2 ? v0[2 * q] : v1[2 * q - 4], ln = q < 2 ? v0[2 * q + 1] : v1[2 * q - 3];
                        const float xg = fminf(gl, 7.0f), xl = fminf(fmaxf(ln, -7.0f), 7.0f); o[q] = xg * sigmoidf_(1.702f * xg) * (xl + 1.0f) * ACT_SCALE; }
                    int w = __builtin_amdgcn_cvt_pk_fp8_f32(o[0], o[1], 0, false); w = __builtin_amdgcn_cvt_pk_fp8_f32(o[2], o[3], w, true);
                    *(int*)(rowp + bj * 64) = w; } }
    }
};
struct EpiMoE2 {
    static constexpr bool PERM = true, AFTER_DRAIN = false;
    const float* b2; bf16_t* YS;
    __device__ __forceinline__ void operator()(const f32x4 (&acc)[2][2][4][2], const Unit& u, int wr, int wc, int fr, int fq) const {
        const int row0 = u.pm * BM + wr * 64 + fr, col0 = u.pn * BM + wc * 32 + 8 * fq;
        const float* bp = b2 + (size_t)u.e * 1024 + col0;
        f32x4 bv[2][2];
#pragma unroll
        for (int bj = 0; bj < 2; ++bj)
#pragma unroll
            for (int n = 0; n < 2; ++n) bv[bj][n] = *(const f32x4*)(bp + bj * HALF + 4 * n);
#pragma unroll
        for (int ai = 0; ai < 2; ++ai)
#pragma unroll
            for (int m = 0; m < 4; ++m) { bf16_t* rowp = YS + (size_t)(row0 + ai * HALF + m * 16) * 1024 + col0;
#pragma unroll
                for (int bj = 0; bj < 2; ++bj) { const f32x4 v0 = acc[ai][bj][m][0] + bv[bj][0], v1 = acc[ai][bj][m][1] + bv[bj][1];
                    u32x4 w; w.x = cvtpk(v0[0], v0[1]); w.y = cvtpk(v0[2], v0[3]); w.z = cvtpk(v1[0], v1[1]); w.w = cvtpk(v1[2], v1[3]);
                    *(u32x4*)(rowp + bj * HALF) = w; } }
    }
};
struct GroupedOrder {
    int nN, G, c; const LAS int* texp; const LAS int* estart; size_t ebytes; int rep;
    __device__ __forceinline__ bool next(int i, Unit& u) const {
        const int ntiles = estart[32] >> 8; long L = (long)i * G + c; if (L >= (long)ntiles * nN * rep) return false; if (L >= (long)ntiles * nN) L -= (long)ntiles * nN;
        u.pm = (int)(L / nN); u.pn = (int)(L % nN); u.e = texp[u.pm]; return true;
    }
    __device__ __forceinline__ const char* baseA(const Gemm& g, const Unit& u, size_t tstep) const { return (const char*)g.A + (size_t)u.pm * tstep; }
    __device__ __forceinline__ const char* baseB(const Gemm& g, const Unit& u, size_t tstep) const { return (const char*)g.Bt + (size_t)u.e * ebytes + (size_t)u.pn * tstep; }
    __device__ __forceinline__ void a_ready(const Unit&) const {}
    __device__ __forceinline__ void done(const Unit&) const {}
};
}

__device__ __forceinline__ void transpose_item64(const float* W, int ldw, bf16_t* WT, int K, int nblk, LAS float* scr, int item, int lane) {
    const int kb = item / nblk, nb = item % nblk, k0 = 64 * kb, n0 = 64 * nb;
    const float* src = W + (size_t)(k0 + (lane >> 4)) * ldw + n0 + 4 * (lane & 15);
    f32x4 v[16];
#pragma unroll
    for (int i = 0; i < 16; ++i) v[i] = *(const f32x4*)(src + (size_t)(4 * i) * ldw);
#pragma unroll
    for (int i = 0; i < 16; ++i) { LAS float* d = scr + ((lane >> 4) + 4 * i) * 65 + 4 * (lane & 15); d[0] = v[i][0]; d[1] = v[i][1]; d[2] = v[i][2]; d[3] = v[i][3]; }
    asm volatile("s_waitcnt lgkmcnt(0)" ::: "memory");
    const int c = lane & 7;
#pragma unroll
    for (int j = 0; j < 8; ++j) { const int n = (lane >> 3) + 8 * j; const LAS float* s = scr + (8 * c) * 65 + n;
        u32x4 o; o.x = cvtpk(s[0 * 65], s[1 * 65]); o.y = cvtpk(s[2 * 65], s[3 * 65]); o.z = cvtpk(s[4 * 65], s[5 * 65]); o.w = cvtpk(s[6 * 65], s[7 * 65]);
        *(u32x4*)(WT + (size_t)(n0 + n) * K + k0 + 8 * c) = o; }
    asm volatile("s_waitcnt lgkmcnt(0)" ::: "memory");
}
__device__ __forceinline__ void transpose_item64_f8(const float* W, int ldw, unsigned char* WT8, int K, int nblk, LAS float* scr, int item, int lane, float sc) {
    const int kb = item / nblk, nb = item % nblk, k0 = 64 * kb, n0 = 64 * nb;
    const float* src = W + (size_t)(k0 + (lane >> 4)) * ldw + n0 + 4 * (lane & 15);
    f32x4 v[16];
#pragma unroll
    for (int i = 0; i < 16; ++i) v[i] = *(const f32x4*)(src + (size_t)(4 * i) * ldw);
#pragma unroll
    for (int i = 0; i < 16; ++i) { LAS float* d = scr + ((lane >> 4) + 4 * i) * 65 + 4 * (lane & 15); d[0] = v[i][0]; d[1] = v[i][1]; d[2] = v[i][2]; d[3] = v[i][3]; }
    asm volatile("s_waitcnt lgkmcnt(0)" ::: "memory");
    const int c = lane & 7;
#pragma unroll
    for (int j = 0; j < 8; ++j) { const int n = (lane >> 3) + 8 * j; const LAS float* s = scr + (8 * c) * 65 + n;
        int d0 = __builtin_amdgcn_cvt_pk_fp8_f32(s[0 * 65] * sc, s[1 * 65] * sc, 0, false); d0 = __builtin_amdgcn_cvt_pk_fp8_f32(s[2 * 65] * sc, s[3 * 65] * sc, d0, true);
        int d1 = __builtin_amdgcn_cvt_pk_fp8_f32(s[4 * 65] * sc, s[5 * 65] * sc, 0, false); d1 = __builtin_amdgcn_cvt_pk_fp8_f32(s[6 * 65] * sc, s[7 * 65] * sc, d1, true);
        *(u32x2*)(WT8 + (size_t)(n0 + n) * K + k0 + 8 * c) = (u32x2){(unsigned)d0, (unsigned)d1}; }
    asm volatile("s_waitcnt lgkmcnt(0)" ::: "memory");
}
__device__ __forceinline__ void p0_prologue(const Params& P, ldsp lds, int tid, int lane, int wave, int bid, int G) {
    unsigned char* ws = P.ws;
    LAS float* scr = (LAS float*)(lds + wave * 16640);
    const int gw = bid * 8 + wave, NGW = G * 8;
    constexpr int I_S0 = 16 * 32, I_S1 = 16 * 48, I_S2 = 16 * 32, I_S3 = 16 * 16, I_SQ = 16 * 16, I_E1 = 16 * 32, I_E2 = 16 * 16;
    constexpr int NITEMS = I_S0 + I_S1 + I_S2 + I_S3 + 3 * I_SQ + 32 * I_E1 + 32 * I_E2;
    for (int it = gw; it < NITEMS; it += NGW) {
        int r = it;
        if (r < I_S0) { transpose_item64(P.w_in, NIN, (bf16_t*)(ws + WS_WIN), 1024, 32, scr, r, lane); continue; } r -= I_S0;
        if (r < I_S1) { transpose_item64(P.w_in + 3072, NIN, (bf16_t*)(ws + WS_WIN) + (size_t)2048 * 1024, 1024, 48, scr, r, lane); continue; } r -= I_S1;
        if (r < I_S2) { transpose_item64(P.w_in + 6160, NIN, (bf16_t*)(ws + WS_WIN) + (size_t)5120 * 1024, 1024, 32, scr, r, lane); continue; } r -= I_S2;
        if (r < I_S3) { transpose_item64(P.w_in + 2048, NIN, (bf16_t*)(ws + WS_WV), 1024, 16, scr, r, lane); continue; } r -= I_S3;
        if (r < I_SQ) { transpose_item64(P.w_o_moba, 1024, (bf16_t*)(ws + WS_WOA), 1024, 16, scr, r, lane); continue; } r -= I_SQ;
        if (r < I_SQ) { transpose_item64(P.w_o_gla, 1024, (bf16_t*)(ws + WS_WOB), 1024, 16, scr, r, lane); continue; } r -= I_SQ;
        if (r < I_SQ) { transpose_item64(P.w_out, 1024, (bf16_t*)(ws + WS_WOUT), 1024, 16, scr, r, lane); continue; } r -= I_SQ;
        if (r < 32 * I_E1) { const int e = r / I_E1; transpose_item64_f8(P.w_exp_in + (size_t)e * 1024 * 2048, 2048, ws + WS_WE1 + (size_t)e * 2048 * 1024, 1024, 32, scr, r % I_E1, lane, WE_SCALE); continue; } r -= 32 * I_E1;
        { const int e = r / I_E2; transpose_item64_f8(P.w_exp_out + (size_t)e * 1024 * 1024, 1024, ws + WS_WE2 + (size_t)e * 1024 * 1024, 1024, 16, scr, r % I_E2, lane, WE_SCALE); }
    }
    float* MODP = (float*)(ws + WS_MODP);
    for (int it = gw; it < 96 * 16; it += NGW) {
        const int g = it % 96, kc = it / 96, col = 64 * g + lane;
        const float c0 = P.c[64 * kc + lane], c1 = P.c[1024 + 64 * kc + lane];
        const float s0 = c0 * sigmoidf_(c0), s1 = c1 * sigmoidf_(c1);
        const float* wp = P.w_ada + (size_t)(64 * kc) * 6144 + col;
        float a0 = 0.f, a1 = 0.f;
#pragma unroll 16
        for (int kk = 0; kk < 64; ++kk) { const float w = wp[(size_t)kk * 6144]; a0 += __shfl(s0, kk) * w; a1 += __shfl(s1, kk) * w; }
        MODP[(kc * 2 + 0) * 6144 + col] = a0; MODP[(kc * 2 + 1) * 6144 + col] = a1;
    }
    { const int g = bid * 512 + tid;
      if (g < SEQ * 16) { const int pos = g >> 4, j = g & 15; const float inv = powf(500000.0f, -(float)j * (1.0f / 16.0f)); const float ang = (float)pos * inv;
          float* rc = (float*)(ws + WS_ROPE); rc[g] = cosf(ang); rc[SEQ * 16 + g] = sinf(ang); } }
}

__device__ __forceinline__ void p1_norm1(const Params& P, ldsp lds, int tid, int lane, int wave, int bid, int G) {
    unsigned char* ws = P.ws;
    const float* MODP = (const float*)(ws + WS_MODP);
    LAS float* A1 = (LAS float*)lds;
    LAS float* B1 = A1 + 2048;
    LAS float* WL = B1 + 2048;
    for (int idx = tid; idx < 2048; idx += 512) { const int b = idx >> 10, c = idx & 1023;
        float sh = P.b_ada[c], sc = P.b_ada[1024 + c];
#pragma unroll
        for (int kc = 0; kc < 16; ++kc) { sh += MODP[(kc * 2 + b) * 6144 + c]; sc += MODP[(kc * 2 + b) * 6144 + 1024 + c]; }
        A1[idx] = P.norm1_w[c] * (1.0f + sc); B1[idx] = sh; }
    for (int idx = tid; idx < 16384; idx += 512) { const int k = idx >> 4, t = idx & 15; WL[t * 1024 + k] = P.w_in[(size_t)k * NIN + 6144 + t]; }
    { const int g = bid * 512 + tid;
      if (g < 2 * 6144) { const int b = g / 6144, n = g % 6144; float s = P.b_ada[n];
#pragma unroll
          for (int kc = 0; kc < 16; ++kc) s += MODP[(kc * 2 + b) * 6144 + n];
          ((float*)(ws + WS_MOD))[g] = s; }
      else if (g < 2 * 6144 + 2048) { const int q = g - 2 * 6144, b = q >> 10, c = q & 1023; float sh = P.b_ada[3072 + c], sc = P.b_ada[4096 + c];
#pragma unroll
          for (int kc = 0; kc < 16; ++kc) { sh += MODP[(kc * 2 + b) * 6144 + 3072 + c]; sc += MODP[(kc * 2 + b) * 6144 + 4096 + c]; }
          float* CO = (float*)(ws + WS_COEF); CO[(b * 2 + 0) * 1024 + c] = P.norm2_w[c] * (1.0f + sc); CO[(b * 2 + 1) * 1024 + c] = sh; } }
    __syncthreads();
    const int gw = bid * 8 + wave, NGW = G * 8;
    bf16_t* H = (bf16_t*)(ws + WS_H); float* GLOW = (float*)(ws + WS_GLOW);
    for (int m = gw; m < M; m += NGW) {
        const int b = m >> 13;
        const f32x4* xr = (const f32x4*)(P.x + (size_t)m * 1024) + lane;
        f32x4 v[4]; float ss = 0.f;
#pragma unroll
        for (int j = 0; j < 4; ++j) { v[j] = xr[64 * j]; ss += (v[j][0] * v[j][0] + v[j][1] * v[j][1]) + (v[j][2] * v[j][2] + v[j][3] * v[j][3]); }
        const float rstd = 1.0f / sqrtf(wave_sum(ss) * (1.0f / 1024.0f) + RMS_EPS);
#pragma unroll
        for (int j = 0; j < 4; ++j) { const f32x4 a = *(const LAS f32x4*)(A1 + b * 1024 + 4 * lane + 256 * j), bb = *(const LAS f32x4*)(B1 + b * 1024 + 4 * lane + 256 * j);
            v[j] = v[j] * rstd * a + bb;
            u32x2 w; w.x = cvtpk(v[j][0], v[j][1]); w.y = cvtpk(v[j][2], v[j][3]);
            *(u32x2*)(H + (size_t)m * 1024 + 4 * lane + 256 * j) = w; }
        float mine = 0.f;
#pragma unroll 2
        for (int t = 0; t < 16; ++t) { float a = 0.f;
#pragma unroll
            for (int j = 0; j < 4; ++j) { const f32x4 wv = *(const LAS f32x4*)(WL + t * 1024 + 4 * lane + 256 * j); a += (v[j][0] * wv[0] + v[j][1] * wv[1]) + (v[j][2] * wv[2] + v[j][3] * wv[3]); }
            const float s = wave_sum(a); if (lane == t) mine = s; }
        if (lane < 16) GLOW[(size_t)m * 16 + lane] = mine;
    }
}

__device__ __forceinline__ void kmean_item(const Params& P, ldsp lds, int item, int tid) {
    const int blk = item & 31, bh = item >> 5, b = bh >> 3, hd = bh & 7;
    const bf16_t* MK = (const bf16_t*)(P.ws + WS_MK);
    const int c = tid & 15, rg = tid >> 4;
    float a[8];
#pragma unroll
    for (int j = 0; j < 8; ++j) a[j] = 0.f;
    const bf16_t* src = MK + (size_t)(b * SEQ + blk * 256 + rg * 8) * 1024 + hd * 128 + c * 8;
#pragma unroll
    for (int i = 0; i < 8; ++i) { const u32x4 v = *(const u32x4*)(src + (size_t)i * 1024);
        a[0] += bflo(v.x); a[1] += bfhi(v.x); a[2] += bflo(v.y); a[3] += bfhi(v.y); a[4] += bflo(v.z); a[5] += bfhi(v.z); a[6] += bflo(v.w); a[7] += bfhi(v.w); }
    LAS float* part = (LAS float*)lds;
#pragma unroll
    for (int j = 0; j < 8; ++j) part[rg * 128 + c * 8 + j] = a[j];
    __syncthreads();
    if (tid < 128) { float s = 0.f;
#pragma unroll 8
        for (int g = 0; g < 32; ++g) s += part[g * 128 + tid];
        s *= (1.0f / 256.0f);
        const unsigned hi = f2bf(s); const unsigned lo = f2bf(s - bf2f(hi));
        bf16_t* KMH = (bf16_t*)(P.ws + WS_KM); KMH[item * 128 + tid] = (bf16_t)hi; KMH[16 * 32 * 128 + item * 128 + tid] = (bf16_t)lo; }
    __syncthreads();
}

constexpr int GL_Q = 0;
constexpr int GL_K = 16384;
constexpr int GL_V = 32768;
constexpr int GL_B = 65536;
constexpr int GL_GLOW = 98304;
constexpr int GL_CS = 102400;
constexpr int GL_BL = 104448;
constexpr int GL_RS = 104960;
typedef short v4i16_t __attribute__((ext_vector_type(4)));
__device__ __forceinline__ unsigned offb(unsigned row, unsigned ch) { return 256u * row + 16u * (ch ^ (((row & 3u) << 2) | ((row >> 2) & 3u))); }
__device__ __forceinline__ s16x4 trread(ldsp img, int lane, int R0, int c) {
    const unsigned blk = (lane >> 4) & 1, q = (lane & 15) >> 2, p = lane & 3;
    const unsigned a = offb((unsigned)R0 + q, 4u * (unsigned)c + 2u * blk + (p >> 1)) + 8u * (p & 1);
    return __builtin_amdgcn_ds_read_tr16_b64_v4i16((LAS v4i16_t*)(img + a));
}
__device__ __forceinline__ void gla_prep(const Params& P, ldsp lds, int tok0, int hg, bool need_q, int tid) {
    const unsigned char* ws = P.ws;
    u32x4 kraw[2], qraw[2], vraw[4];
    { const bf16_t* GK = (const bf16_t*)(ws + WS_GK) + (size_t)tok0 * 512 + 128 * hg; const bf16_t* GQ = (const bf16_t*)(ws + WS_GQ) + (size_t)tok0 * 512 + 128 * hg;
      const bf16_t* GV = (const bf16_t*)(ws + WS_GV) + (size_t)tok0 * 1024 + 256 * hg;
#pragma unroll
      for (int i = 0; i < 2; ++i) { const int p = tid + 512 * i; kraw[i] = *(const u32x4*)(GK + (size_t)(p >> 4) * 512 + 8 * (p & 15)); if (need_q) qraw[i] = *(const u32x4*)(GQ + (size_t)(p >> 4) * 512 + 8 * (p & 15)); }
#pragma unroll
      for (int i = 0; i < 4; ++i) { const int p = tid + 512 * i; vraw[i] = *(const u32x4*)(GV + (size_t)(p >> 5) * 1024 + 8 * (p & 31)); } }
    if (tid < 256) { const f32x4 v = *(const f32x4*)((const float*)(ws + WS_GLOW) + (size_t)tok0 * 16 + tid * 4); *(LAS f32x4*)(lds + GL_GLOW + tid * 16) = v; }
    const int d = tid & 127, rq = tid >> 7;
    float gw[16];
#pragma unroll
    for (int t = 0; t < 16; ++t) gw[t] = P.gla_gate_w[t * 512 + 128 * hg + d];
    const float gb = P.gla_gate_b[128 * hg + d];
    __syncthreads();
    float bl[16]; float run = 0.f;
    const LAS float* glw = (const LAS float*)(lds + GL_GLOW);
#pragma unroll
    for (int i = 0; i < 16; ++i) { const int row = 16 * rq + i; float z = gb;
#pragma unroll
        for (int t4 = 0; t4 < 4; ++t4) { const f32x4 gv = *(const LAS f32x4*)(glw + row * 16 + 4 * t4); z += gv[0] * gw[4 * t4] + gv[1] * gw[4 * t4 + 1] + gv[2] * gw[4 * t4 + 2] + gv[3] * gw[4 * t4 + 3]; }
        const float ls = fminf(z, 0.f) - __logf(1.0f + __expf(-fabsf(z)));
        run += ls * (1.0f / 16.0f); bl[i] = run; }
    LAS float* CS = (LAS float*)(lds + GL_CS);
    CS[rq * 128 + d] = run;
    __syncthreads();
    float pre = 0.f, tot = 0.f;
#pragma unroll
    for (int q = 0; q < 4; ++q) { const float c = CS[q * 128 + d]; tot += c; if (q < rq) pre += c; }
    if (rq == 0) ((LAS float*)(lds + GL_BL))[d] = tot;
    LAS float* BI = (LAS float*)(lds + GL_B);
#pragma unroll
    for (int i = 0; i < 16; ++i) BI[(16 * rq + i) * 128 + d] = pre + bl[i];
    __syncthreads();
    const LAS float* BL = (const LAS float*)(lds + GL_BL);
#pragma unroll
    for (int i = 0; i < 2; ++i) { const int p = tid + 512 * i, row = p >> 4, ch = p & 15;
        const f32x4 b0 = *(const LAS f32x4*)(BI + row * 128 + 8 * ch), b1 = *(const LAS f32x4*)(BI + row * 128 + 8 * ch + 4), t0 = *(const LAS f32x4*)(BL + 8 * ch), t1 = *(const LAS f32x4*)(BL + 8 * ch + 4);
        float e[8];
#pragma unroll
        for (int j = 0; j < 4; ++j) { e[j] = __expf(t0[j] - b0[j]); e[4 + j] = __expf(t1[j] - b1[j]); }
        const u32x4 k = kraw[i]; u32x4 w;
        w.x = cvtpk(bflo(k.x) * e[0], bfhi(k.x) * e[1]); w.y = cvtpk(bflo(k.y) * e[2], bfhi(k.y) * e[3]); w.z = cvtpk(bflo(k.z) * e[4], bfhi(k.z) * e[5]); w.w = cvtpk(bflo(k.w) * e[6], bfhi(k.w) * e[7]);
        *(LAS u32x4*)(lds + GL_K + offb(row, ch)) = w;
        if (need_q) { const u32x4 q = qraw[i]; u32x4 wq;
            wq.x = cvtpk(bflo(q.x) / e[0], bfhi(q.x) / e[1]); wq.y = cvtpk(bflo(q.y) / e[2], bfhi(q.y) / e[3]); wq.z = cvtpk(bflo(q.z) / e[4], bfhi(q.z) / e[5]); wq.w = cvtpk(bflo(q.w) / e[6], bfhi(q.w) / e[7]);
            *(LAS u32x4*)(lds + GL_Q + offb(row, ch)) = wq; } }
#pragma unroll
    for (int i = 0; i < 4; ++i) { const int p = tid + 512 * i, row = p >> 5, c32 = p & 31; *(LAS u32x4*)(lds + GL_V + (c32 >> 4) * 16384 + offb(row, c32 & 15)) = vraw[i]; }
    __syncthreads();
}
template <bool PHASE_C>
__device__ __forceinline__ void gla_unit(const Params& P, ldsp lds, int bh8, int g, int tid_in, int lane_in, int wave) {
    unsigned char* ws = P.ws;
    const int b = bh8 >> 2, hg = bh8 & 3;
    int tid = tid_in, lane = lane_in; int r = lane & 31, h = lane >> 5;
    f32x16 S[4];
    float* GS = (float*)(ws + WS_GS) + (size_t)(bh8 * 32 + g) * 128 * 256;
#pragma unroll
    for (int dkb = 0; dkb < 4; ++dkb)
#pragma unroll
        for (int reg = 0; reg < 16; ++reg) S[dkb][reg] = PHASE_C ? GS[(size_t)(32 * dkb + crow(reg, h)) * 256 + 32 * wave + r] : 0.f;
    float bsum = 0.f;
    const LAS float* BL = (const LAS float*)(lds + GL_BL);
    const ldsp vimg = lds + GL_V + (wave >> 2) * 16384; const int vc = wave & 3;
    for (int ch = 0; ch < 4; ++ch) {
        tid = tid_in; asm volatile("" : "+v"(tid)); lane = tid & 63; r = lane & 31; h = lane >> 5;
        const int tok0 = b * SEQ + (g * 4 + ch) * 64;
        gla_prep(P, lds, tok0, hg, PHASE_C, tid);
#pragma unroll
        for (int dkb = 0; dkb < 4; ++dkb)
#pragma unroll
            for (int reg = 0; reg < 16; ++reg) S[dkb][reg] *= __expf(BL[32 * dkb + crow(reg, h)]);
        if (tid < 128) bsum += BL[tid];
        __builtin_amdgcn_sched_barrier(0);
        if (PHASE_C) {
            f32x16 at00, at01, at11;
#pragma unroll
            for (int i = 0; i < 16; ++i) { at00[i] = 0.f; at01[i] = 0.f; at11[i] = 0.f; }
#pragma unroll
            for (int s = 0; s < 8; ++s) {
                const unsigned a0 = offb(r, 2 * s + h), a1 = offb(32 + r, 2 * s + h);
                const bf16x8 ka0 = *(const LAS bf16x8*)(lds + GL_K + a0), ka1 = *(const LAS bf16x8*)(lds + GL_K + a1);
                const bf16x8 qb0 = *(const LAS bf16x8*)(lds + GL_Q + a0), qb1 = *(const LAS bf16x8*)(lds + GL_Q + a1);
                at00 = MFMA32(ka0, qb0, at00); at01 = MFMA32(ka0, qb1, at01); at11 = MFMA32(ka1, qb1, at11);
                if (s & 1) __builtin_amdgcn_sched_barrier(0);
            }
#pragma unroll
            for (int reg = 0; reg < 16; ++reg) { if (crow(reg, h) > r) { at00[reg] = 0.f; at11[reg] = 0.f; } }
            f32x16 ot0, ot1;
#pragma unroll
            for (int i = 0; i < 16; ++i) { ot0[i] = 0.f; ot1[i] = 0.f; }
#pragma unroll
            for (int dkb = 0; dkb < 4; ++dkb) {
                const bf16x8 sa0 = pack8<0>(S[dkb]), sa1 = pack8<1>(S[dkb]);
#pragma unroll
                for (int s = 0; s < 2; ++s) {
                    const unsigned chq = 4 * dkb + 2 * s;
                    const bf16x8 q0 = cat44(*(const LAS s16x4*)(lds + GL_Q + offb(r, chq) + 8 * h), *(const LAS s16x4*)(lds + GL_Q + offb(r, chq + 1) + 8 * h));
                    const bf16x8 q1 = cat44(*(const LAS s16x4*)(lds + GL_Q + offb(32 + r, chq) + 8 * h), *(const LAS s16x4*)(lds + GL_Q + offb(32 + r, chq + 1) + 8 * h));
                    ot0 = MFMA32(s == 0 ? sa0 : sa1, q0, ot0); ot1 = MFMA32(s == 0 ? sa0 : sa1, q1, ot1);
                }
                __builtin_amdgcn_sched_barrier(0);
            }
            {
                const bf16x8 p00a = pack8<0>(at00), p00b = pack8<1>(at00), p01a = pack8<0>(at01), p01b = pack8<1>(at01), p11a = pack8<0>(at11), p11b = pack8<1>(at11);
#pragma unroll
                for (int s = 0; s < 2; ++s) {
                    const bf16x8 v0 = cat44(trread(vimg, lane, 16 * s + 4 * h, vc), trread(vimg, lane, 16 * s + 4 * h + 8, vc));
                    const bf16x8 v1 = cat44(trread(vimg, lane, 32 + 16 * s + 4 * h, vc), trread(vimg, lane, 32 + 16 * s + 4 * h + 8, vc));
                    ot0 = MFMA32(v0, s == 0 ? p00a : p00b, ot0);
                    ot1 = MFMA32(v0, s == 0 ? p01a : p01b, ot1);
                    ot1 = MFMA32(v1, s == 0 ? p11a : p11b, ot1);
                }
            }
            __builtin_amdgcn_sched_barrier(0);
            LAS float* RS = (LAS float*)(lds + GL_RS);
            float q0 = 0.f, q1 = 0.f;
#pragma unroll
            for (int i = 0; i < 16; ++i) { q0 += ot0[i] * ot0[i]; q1 += ot1[i] * ot1[i]; }
            q0 += __shfl_xor(q0, 32); q1 += __shfl_xor(q1, 32);
            if (h == 0) { RS[wave * 64 + r] = q0; RS[wave * 64 + 32 + r] = q1; }
            __syncthreads();
            float t0 = 0.f, t1 = 0.f;
#pragma unroll
            for (int w = 0; w < 8; ++w) { t0 += RS[w * 64 + r]; t1 += RS[w * 64 + 32 + r]; }
            const float rs0 = 1.0f / sqrtf(t0 * (1.0f / 256.0f) + RMS_EPS), rs1 = 1.0f / sqrtf(t1 * (1.0f / 256.0f) + RMS_EPS);
            const bf16_t* GR = (const bf16_t*)(ws + WS_GR); bf16_t* OB = (bf16_t*)(ws + WS_OB);
#pragma unroll
            for (int ib = 0; ib < 2; ++ib) {
                const size_t rowoff = (size_t)(tok0 + 32 * ib + r) * 1024 + 256 * hg + 32 * wave;
#pragma unroll
                for (int rq = 0; rq < 4; ++rq) { const int dvl = 8 * rq + 4 * h;
                    const u32x2 gr = *(const u32x2*)(GR + rowoff + dvl);
                    const f32x4 nw = *(const f32x4*)(P.gla_norm_w + 32 * wave + dvl);
                    const float rs = ib == 0 ? rs0 : rs1;
                    float o[4];
#pragma unroll
                    for (int i = 0; i < 4; ++i) o[i] = (ib == 0 ? ot0[4 * rq + i] : ot1[4 * rq + i]) * rs * nw[i];
                    o[0] *= bflo(gr.x); o[1] *= bfhi(gr.x); o[2] *= bflo(gr.y); o[3] *= bfhi(gr.y);
                    u32x2 w; w.x = cvtpk(o[0], o[1]); w.y = cvtpk(o[2], o[3]);
                    *(u32x2*)(OB + rowoff + dvl) = w; }
            }
        }
        __builtin_amdgcn_sched_barrier(0);
#pragma unroll
        for (int s = 0; s < 4; ++s) {
            const bf16x8 vb = cat44(trread(vimg, lane, 16 * s + 8 * h, vc), trread(vimg, lane, 16 * s + 8 * h + 4, vc));
#pragma unroll
            for (int dkb = 0; dkb < 4; ++dkb) { const bf16x8 ka = cat44(trread(lds + GL_K, lane, 16 * s + 8 * h, dkb), trread(lds + GL_K, lane, 16 * s + 8 * h + 4, dkb)); S[dkb] = MFMA32(ka, vb, S[dkb]); }
            __builtin_amdgcn_sched_barrier(0);
        }
        __syncthreads();
    }
    if (!PHASE_C) {
        float* TG = (float*)(ws + WS_TG) + (size_t)(bh8 * 32 + g) * 128 * 256;
#pragma unroll
        for (int dkb = 0; dkb < 4; ++dkb)
#pragma unroll
            for (int reg = 0; reg < 16; ++reg) TG[(size_t)(32 * dkb + crow(reg, h)) * 256 + 32 * wave + r] = S[dkb][reg];
        if (tid < 128) ((float*)(ws + WS_DG))[(bh8 * 32 + g) * 128 + tid] = __expf(bsum);
    }
}
__device__ __forceinline__ void gla_scan(const Params& P, int tid, int bid) {
    const float* TG = (const float*)(P.ws + WS_TG); const float* DG = (const float*)(P.ws + WS_DG); float* GS = (float*)(P.ws + WS_GS);
#pragma unroll 1
    for (int rep = 0; rep < 2; ++rep) {
        const int e = bid * 512 + tid + rep * 131072; const int bh8 = e >> 15, dk = (e >> 8) & 127, dv = e & 255;
        const size_t off0 = ((size_t)(bh8 * 32) * 128 + dk) * 256 + dv;
        float tg[32], dg[32];
#pragma unroll
        for (int g = 0; g < 32; ++g) { tg[g] = TG[off0 + (size_t)g * 128 * 256]; dg[g] = DG[(bh8 * 32 + g) * 128 + dk]; }
        float G = 0.f;
#pragma unroll
        for (int g = 0; g < 32; ++g) { GS[off0 + (size_t)g * 128 * 256] = G; G = dg[g] * G + tg[g]; }
    }
}

constexpr size_t WS_PART = 640 * MiB;
constexpr size_t WS_ML = 768 * MiB;
constexpr size_t WS_LIST = 772 * MiB;
constexpr int CW_LCNT = 32768;
constexpr int CW_QHEAD = 40960;
constexpr int AT2_K = 0;
constexpr int AT2_V = 69632;
__device__ __forceinline__ void moba_select_unit(const Params& P, ldsp lds, int b, int hd, int blk, int tid, int lane, int wave) {
    unsigned char* ws = P.ws;
    const int r = lane & 31, h = lane >> 5, bh = b * 8 + hd;
    LAS int* HB = (LAS int*)lds; LAS int* GBASE = HB + 32;
    if (tid < 32) HB[tid] = 0;
    unsigned sel = 0u;
    if (blk > 0) {
        const bf16_t* MQ = (const bf16_t*)(ws + WS_MQ);
        const int tokq = b * SEQ + 256 * blk + 32 * wave + r;
        bf16x8 qr[8];
#pragma unroll
        for (int s = 0; s < 8; ++s) qr[s] = *(const bf16x8*)(MQ + (size_t)tokq * 1024 + 128 * hd + 16 * s + 8 * h);
        const bf16_t* KMH = (const bf16_t*)(ws + WS_KM) + (size_t)(bh * 32 + r) * 128; const bf16_t* KML = KMH + 16 * 32 * 128;
        f32x16 gt;
#pragma unroll
        for (int i = 0; i < 16; ++i) gt[i] = 0.f;
#pragma unroll
        for (int s = 0; s < 8; ++s) { const bf16x8 a = *(const bf16x8*)(KMH + 16 * s + 8 * h), a2 = *(const bf16x8*)(KML + 16 * s + 8 * h); gt = MFMA32(a, qr[s], gt); gt = MFMA32(a2, qr[s], gt); }
#pragma unroll
        for (int round = 0; round < 3; ++round) {
            float best = -INFINITY; int bn = 64;
#pragma unroll
            for (int reg = 0; reg < 16; ++reg) { const int n = crow(reg, h); const bool ok = (n < blk) && !((sel >> n) & 1u); if (ok && gt[reg] > best) { best = gt[reg]; bn = n; } }
            const float ob = __shfl_xor(best, 32); const int on = __shfl_xor(bn, 32);
            if (ob > best || (ob == best && on < bn)) { best = ob; bn = on; }
            if (bn < 64) sel |= 1u << bn;
        }
    }
    __syncthreads();
    int pn[3] = {0, 0, 0}, pr[3] = {0, 0, 0}; int nsel = 0;
    if (h == 0) { unsigned mm = sel;
#pragma unroll
        for (int s = 0; s < 3; ++s) if (mm) { const int n = __builtin_ctz(mm); mm &= mm - 1; pn[s] = n; pr[s] = __hip_atomic_fetch_add(HB + n, 1, __ATOMIC_RELAXED, __HIP_MEMORY_SCOPE_WORKGROUP); nsel = s + 1; } }
    __syncthreads();
    if (tid < 32) { const int c = HB[tid]; if (c > 0) GBASE[tid] = (int)atomicAdd((unsigned*)(ws + WS_CTL) + CW_LCNT + bh * 32 + tid, (unsigned)c); }
    __syncthreads();
    if (h == 0) { const int ql = 256 * blk + 32 * wave + r; unsigned* LIST = (unsigned*)(ws + WS_LIST); float* ML = (float*)(ws + WS_ML);
#pragma unroll
        for (int s = 0; s < 3; ++s) {
            if (s < nsel) LIST[(size_t)(bh * 32 + pn[s]) * 8192 + GBASE[pn[s]] + pr[s]] = (unsigned)ql | ((unsigned)s << 13);
            else { const size_t mi = ((size_t)(bh * 8192 + ql) * 4 + s) * 2; ML[mi] = -1e30f; ML[mi + 1] = 0.f; } } }
    __syncthreads();
}
__device__ __forceinline__ void moba_item_table(const Params& P, ldsp lds, int lane, int wave) {
    LAS int* IPFX = (LAS int*)(lds + IPFX_OFF);
    if (wave == 0) { const unsigned* LC = (const unsigned*)(P.ws + WS_CTL) + CW_LCNT;
        int v[8]; int s = 0;
#pragma unroll
        for (int j = 0; j < 8; ++j) { const int o = lane * 8 + j; const int cnt = (int)__hip_atomic_load(LC + (o & 15) * 32 + (o >> 4), __ATOMIC_RELAXED, __HIP_MEMORY_SCOPE_AGENT);
            const int nch = 1 + ((cnt + 255) >> 8); v[j] = (nch + 3) >> 2; s += v[j]; }
        int incl = s;
#pragma unroll
        for (int o = 1; o < 64; o <<= 1) { const int t = __shfl_up(incl, o); if (lane >= o) incl += t; }
        int excl = incl - s;
#pragma unroll
        for (int j = 0; j < 8; ++j) { IPFX[lane * 8 + j] = excl; excl += v[j]; }
        if (lane == 63) IPFX[512] = incl; }
    __syncthreads();
}
__device__ __forceinline__ void moba_item(const Params& P, ldsp lds, int ia, int tid_in, int wave) {
    unsigned char* ws = P.ws;
    const LAS int* IPFX = (const LAS int*)(lds + IPFX_OFF);
    int lo = 0, hi = 512;
    while (hi - lo > 1) { const int mid = (lo + hi) >> 1; if (IPFX[mid] <= ia) lo = mid; else hi = mid; }
    const int o_ = __builtin_amdgcn_readfirstlane(lo);
    const int n = o_ >> 4, bh = o_ & 15, b = bh >> 3, hd = bh & 7;
    const int cnt = __builtin_amdgcn_readfirstlane((int)__hip_atomic_load((const unsigned*)(ws + WS_CTL) + CW_LCNT + bh * 32 + n, __ATOMIC_RELAXED, __HIP_MEMORY_SCOPE_AGENT));
    const int nch = 1 + ((cnt + 255) >> 8); const int c0 = 4 * (ia - IPFX[o_]); const int c1 = (c0 + 4 < nch) ? c0 + 4 : nch;
    const bf16_t* MQ = (const bf16_t*)(ws + WS_MQ);
    {
        int tid = tid_in; asm volatile("" : "+v"(tid));
        const bf16_t* Kg = (const bf16_t*)(ws + WS_MK) + (size_t)(b * SEQ + 256 * n) * 1024 + 128 * hd;
        const bf16_t* Vg = (const bf16_t*)(ws + WS_VT) + (size_t)(128 * hd) * M + (size_t)b * SEQ + 256 * n;
#pragma unroll
        for (int hf = 0; hf < 2; ++hf) {
            u32x4 kv[4], vv[4];
#pragma unroll
            for (int i = 0; i < 4; ++i) { const int p = tid + 512 * (4 * hf + i); kv[i] = *(const u32x4*)(Kg + (size_t)(p >> 4) * 1024 + 8 * (p & 15)); vv[i] = *(const u32x4*)(Vg + (size_t)(p >> 5) * M + 8 * (p & 31)); }
#pragma unroll
            for (int i = 0; i < 4; ++i) { const int p = tid + 512 * (4 * hf + i);
                *(LAS u32x4*)(lds + AT2_K + (p >> 4) * 272 + 16 * (p & 15)) = kv[i];
                *(LAS u32x2*)(lds + AT2_V + (p >> 5) * 520 + 16 * (p & 31)) = (u32x2){vv[i].x, vv[i].y}; *(LAS u32x2*)(lds + AT2_V + (p >> 5) * 520 + 16 * (p & 31) + 8) = (u32x2){vv[i].z, vv[i].w}; }
        }
    }
    __syncthreads();
    for (int c = c0; c < c1; ++c) {
        int tid = tid_in; asm volatile("" : "+v"(tid)); const int lane = tid & 63, r = lane & 31, h = lane >> 5;
        const bool own = (c == 0);
        const int idx0 = (c - 1) * 256 + 32 * wave;
        if (!own && idx0 >= cnt) continue;
        int ql, slot; bool valid = true;
        if (own) { ql = 256 * n + 32 * wave + r; slot = 3; }
        else { const int idx = idx0 + r; valid = idx < cnt; const unsigned e = ((const unsigned*)(ws + WS_LIST))[(size_t)(bh * 32 + n) * 8192 + (valid ? idx : cnt - 1)]; ql = (int)(e & 8191u); slot = (int)(e >> 13); }
        bf16x8 qr[8];
        { const bf16_t* qp = MQ + (size_t)(b * SEQ + ql) * 1024 + 128 * hd + 8 * h;
#pragma unroll
          for (int s = 0; s < 8; ++s) qr[s] = *(const bf16x8*)(qp + 16 * s); }
        f32x16 o[4];
#pragma unroll
        for (int db = 0; db < 4; ++db)
#pragma unroll
            for (int i = 0; i < 16; ++i) o[db][i] = 0.f;
        float mrun = -1e30f, lrun = 0.f;
        const int tmax = own ? ((32 * wave + 31) >> 6) : 3;
        for (int t = 0; t <= tmax; ++t) {
            f32x16 p0, p1;
#pragma unroll
            for (int i = 0; i < 16; ++i) { p0[i] = 0.f; p1[i] = 0.f; }
            const int krow = AT2_K + (64 * t + r) * 272 + 16 * h;
#pragma unroll
            for (int s = 0; s < 8; ++s) {
                const bf16x8 ka = *(const LAS bf16x8*)(lds + krow + 32 * s), kb = *(const LAS bf16x8*)(lds + krow + 32 * 272 + 32 * s);
                p0 = MFMA32(ka, qr[s], p0); p1 = MFMA32(kb, qr[s], p1);
            }
            if (own) { const int qloc = 32 * wave + r;
#pragma unroll
                for (int reg = 0; reg < 16; ++reg) { const int kl = 64 * t + crow(reg, h); if (kl > qloc) p0[reg] = -INFINITY; if (kl + 32 > qloc) p1[reg] = -INFINITY; } }
            float tm = fmaxf(p0[0], p1[0]);
#pragma unroll
            for (int reg = 1; reg < 16; ++reg) tm = fmaxf(tm, fmaxf(p0[reg], p1[reg]));
            tm = fmaxf(tm, __shfl_xor(tm, 32));
            const float mnew = fmaxf(mrun, tm);
            const float f = __builtin_amdgcn_exp2f(mrun - mnew);
            mrun = mnew;
            float ps = 0.f;
#pragma unroll
            for (int reg = 0; reg < 16; ++reg) { p0[reg] = __builtin_amdgcn_exp2f(p0[reg] - mnew); p1[reg] = __builtin_amdgcn_exp2f(p1[reg] - mnew); ps += p0[reg] + p1[reg]; }
            lrun = lrun * f + ps;
            if (!__all(f == 1.0f)) {
#pragma unroll
                for (int db = 0; db < 4; ++db)
#pragma unroll
                    for (int i = 0; i < 16; ++i) o[db][i] *= f; }
            const bf16x8 pf0 = pack8<0>(p0), pf1 = pack8<1>(p0), pf2 = pack8<0>(p1), pf3 = pack8<1>(p1);
#pragma unroll
            for (int db = 0; db < 4; ++db) {
                const int vrow = AT2_V + (32 * db + r) * 520 + (64 * t + 4 * h) * 2;
#pragma unroll
                for (int ks = 0; ks < 4; ++ks) {
                    const bf16x8 vf = cat44(*(const LAS s16x4*)(lds + vrow + 32 * ks), *(const LAS s16x4*)(lds + vrow + 32 * ks + 16));
                    o[db] = MFMA32(vf, ks == 0 ? pf0 : ks == 1 ? pf1 : ks == 2 ? pf2 : pf3, o[db]);
                }
            }
        }
        lrun += __shfl_xor(lrun, 32);
        const float inv = 1.0f / lrun;
        if (valid) {
            const size_t pi = (size_t)(bh * 8192 + ql) * 4 + slot;
            bf16_t* PO = (bf16_t*)(ws + WS_PART) + pi * 128;
#pragma unroll
            for (int db = 0; db < 4; ++db)
#pragma unroll
                for (int rq = 0; rq < 4; ++rq) { u32x2 w; w.x = cvtpk(o[db][4 * rq] * inv, o[db][4 * rq + 1] * inv); w.y = cvtpk(o[db][4 * rq + 2] * inv, o[db][4 * rq + 3] * inv);
                    *(u32x2*)(PO + 32 * db + 8 * rq + 4 * h) = w; }
            if (h == 0) { float* ML = (float*)(ws + WS_ML) + pi * 2; ML[0] = mrun; ML[1] = lrun; }
        }
    }
    __syncthreads();
}
__device__ __forceinline__ void moba_combine(const Params& P, int lane, int wave, int bid, int G) {
    unsigned char* ws = P.ws;
    const bf16_t* PART = (const bf16_t*)(ws + WS_PART); const float* ML = (const float*)(ws + WS_ML); bf16_t* OA = (bf16_t*)(ws + WS_OA);
    const int gw = bid * 8 + wave, NGW = G * 8, hd = lane >> 3, dc = lane & 7;
    for (int tok = gw; tok < M; tok += NGW) {
        const int b = tok >> 13, q = tok & (SEQ - 1); const size_t base = (size_t)((b * 8 + hd) * 8192 + q) * 4;
        float ms[4], ls[4]; float mx = -1e30f;
#pragma unroll
        for (int s = 0; s < 4; ++s) { const f32x2_t ml = *(const f32x2_t*)(ML + (base + s) * 2); ms[s] = ml[0]; ls[s] = ml[1]; mx = fmaxf(mx, ml[1] > 0.f ? ml[0] : -1e30f); }
        float acc[16]; float wsum = 0.f;
#pragma unroll
        for (int j = 0; j < 16; ++j) acc[j] = 0.f;
#pragma unroll
        for (int s = 0; s < 4; ++s) {
            if (ls[s] > 0.f) { const float w = ls[s] * __builtin_amdgcn_exp2f(ms[s] - mx); wsum += w;
                const u32x4 a = *(const u32x4*)(PART + (base + s) * 128 + 16 * dc), c = *(const u32x4*)(PART + (base + s) * 128 + 16 * dc + 8);
                acc[0] += w * bflo(a.x); acc[1] += w * bfhi(a.x); acc[2] += w * bflo(a.y); acc[3] += w * bfhi(a.y); acc[4] += w * bflo(a.z); acc[5] += w * bfhi(a.z); acc[6] += w * bflo(a.w); acc[7] += w * bfhi(a.w);
                acc[8] += w * bflo(c.x); acc[9] += w * bfhi(c.x); acc[10] += w * bflo(c.y); acc[11] += w * bfhi(c.y); acc[12] += w * bflo(c.z); acc[13] += w * bfhi(c.z); acc[14] += w * bflo(c.w); acc[15] += w * bfhi(c.w); } }
        const float inv = 1.0f / wsum;
        u32x4 o0, o1;
        o0.x = cvtpk(acc[0] * inv, acc[1] * inv); o0.y = cvtpk(acc[2] * inv, acc[3] * inv); o0.z = cvtpk(acc[4] * inv, acc[5] * inv); o0.w = cvtpk(acc[6] * inv, acc[7] * inv);
        o1.x = cvtpk(acc[8] * inv, acc[9] * inv); o1.y = cvtpk(acc[10] * inv, acc[11] * inv); o1.z = cvtpk(acc[12] * inv, acc[13] * inv); o1.w = cvtpk(acc[14] * inv, acc[15] * inv);
        bf16_t* op = OA + (size_t)tok * 1024 + 128 * hd + 16 * dc;
        *(u32x4*)op = o0; *(u32x4*)(op + 8) = o1;
    }
}

__device__ __forceinline__ void p8_router(const Params& P, ldsp lds, int tid, int lane, int wave, int bid, int G) {
    unsigned char* ws = P.ws;
    LAS float* WR = (LAS float*)lds;
    for (int idx = tid; idx < 32768; idx += 512) { const int c = idx >> 5, e = idx & 31; WR[e * 1024 + c] = P.w_router[idx]; }
    LAS int* LH = (LAS int*)(lds + LH_OFF); LAS int* LBASE = (LAS int*)(lds + LBASE_OFF);
    if (tid < 32) LH[tid] = 0;
    __syncthreads();
    const float* X1 = (const float*)(ws + WS_X1); const float* CO = (const float*)(ws + WS_COEF); unsigned char* H = ws + WS_H;
    const int gw = bid * 8 + wave, NGW = G * 8;
    int rec_e = 0, rec_r = 0, rec_m = -1; float rec_w = 0.f;
    int it = 0;
    for (int m = gw; m < M; m += NGW, ++it) {
        const int b = m >> 13;
        const f32x4* xr = (const f32x4*)(X1 + (size_t)m * 1024) + lane;
        f32x4 v[4]; float ss = 0.f;
#pragma unroll
        for (int j = 0; j < 4; ++j) { v[j] = xr[64 * j]; ss += (v[j][0] * v[j][0] + v[j][1] * v[j][1]) + (v[j][2] * v[j][2] + v[j][3] * v[j][3]); }
        const float rstd = 1.0f / sqrtf(wave_sum(ss) * (1.0f / 1024.0f) + RMS_EPS);
#pragma unroll
        for (int j = 0; j < 4; ++j) { const f32x4 a = *(const f32x4*)(CO + (b * 2 + 0) * 1024 + 4 * lane + 256 * j), bb = *(const f32x4*)(CO + (b * 2 + 1) * 1024 + 4 * lane + 256 * j);
            v[j] = v[j] * rstd * a + bb;
            int w = __builtin_amdgcn_cvt_pk_fp8_f32(v[j][0] * H2_SCALE, v[j][1] * H2_SCALE, 0, false); w = __builtin_amdgcn_cvt_pk_fp8_f32(v[j][2] * H2_SCALE, v[j][3] * H2_SCALE, w, true);
            *(int*)(H + (size_t)m * 1024 + 4 * lane + 256 * j) = w; }
        float lg[32];
#pragma unroll
        for (int e = 0; e < 32; ++e) { float a = 0.f;
#pragma unroll
            for (int j = 0; j < 4; ++j) { const f32x4 wv = *(const LAS f32x4*)(WR + e * 1024 + 4 * lane + 256 * j); a += (v[j][0] * wv[0] + v[j][1] * wv[1]) + (v[j][2] * wv[2] + v[j][3] * wv[3]); }
            lg[e] = wave_sum(a) + P.b_router[e]; }
        unsigned used = 0u; int te[4]; float tl[4];
#pragma unroll
        for (int k = 0; k < 4; ++k) { float best = -INFINITY; int be = 0;
#pragma unroll
            for (int e = 0; e < 32; ++e) { const bool ok = !((used >> e) & 1u); if (ok && lg[e] > best) { best = lg[e]; be = e; } }
            used |= 1u << be; te[k] = be; tl[k] = best; }
        const float e1 = __expf(tl[1] - tl[0]), e2 = __expf(tl[2] - tl[0]), e3 = __expf(tl[3] - tl[0]); const float isum = 1.0f / (1.0f + e1 + e2 + e3);
        const float tw[4] = {isum, e1 * isum, e2 * isum, e3 * isum};
        if ((lane >> 2) == it) { const int k = lane & 3; rec_e = k == 0 ? te[0] : k == 1 ? te[1] : k == 2 ? te[2] : te[3]; rec_w = k == 0 ? tw[0] : k == 1 ? tw[1] : k == 2 ? tw[2] : tw[3]; rec_m = m;
            rec_r = __hip_atomic_fetch_add(LH + rec_e, 1, __ATOMIC_RELAXED, __HIP_MEMORY_SCOPE_WORKGROUP); }
    }
    __syncthreads();
    if (tid < 32) LBASE[tid] = (int)atomicAdd((unsigned*)(ws + WS_CTL) + CW_CNT + 64 * tid, (unsigned)LH[tid]);
    __syncthreads();
    if (rec_m >= 0) { const int k = lane & 3; int* TOPE = (int*)(ws + WS_ROUTE); float* TOPW = (float*)(ws + WS_ROUTE + 256 * 1024); int* RANK = (int*)(ws + WS_ROUTE + 512 * 1024);
        TOPE[rec_m * 4 + k] = rec_e; TOPW[rec_m * 4 + k] = rec_w; RANK[rec_m * 4 + k] = LBASE[rec_e] + rec_r; }
}

__device__ __forceinline__ void p9_layout(const Params& P, ldsp lds, int tid) {
    LAS int* TEXP = (LAS int*)(lds + TEXP_OFF); LAS int* EST = (LAS int*)(lds + ESTART_OFF);
    if (tid == 0) { int acc = 0; const unsigned* cnt = (const unsigned*)(P.ws + WS_CTL) + CW_CNT;
        for (int e = 0; e < 32; ++e) { const int c = (int)__hip_atomic_load(cnt + 64 * e, __ATOMIC_RELAXED, __HIP_MEMORY_SCOPE_AGENT); const int pad = (c + 255) & ~255; EST[e] = acc;
            for (int t = acc >> 8; t < (acc + pad) >> 8; ++t) TEXP[t] = e; acc += pad; }
        EST[32] = acc; }
    __syncthreads();
}
__device__ __forceinline__ void p9_gather(const Params& P, ldsp lds, int tid, int lane, int wave, int bid, int G) {
    unsigned char* ws = P.ws;
    const LAS int* EST = (const LAS int*)(lds + ESTART_OFF);
    const int* TOPE = (const int*)(ws + WS_ROUTE); const int* RANK = (const int*)(ws + WS_ROUTE + 512 * 1024); int* POS = (int*)(ws + WS_ROUTE + 768 * 1024);
    const unsigned char* H = ws + WS_H; unsigned char* XP = ws + WS_XP;
    const int gw = bid * 8 + wave, NGW = G * 8;
    for (int m = gw; m < M; m += NGW) {
        int pos = 0;
        if (lane < 4) { pos = EST[TOPE[m * 4 + lane]] + RANK[m * 4 + lane]; POS[m * 4 + lane] = pos; }
        const u32x4 a = *(const u32x4*)(H + (size_t)m * 1024 + 16 * lane);
#pragma unroll
        for (int k = 0; k < 4; ++k) { const int pk = __shfl(pos, k); *(u32x4*)(XP + (size_t)pk * 1024 + 16 * lane) = a; }
    }
}

__device__ __forceinline__ void p12_final(const Params& P, int lane, int wave, int bid, int G) {
    unsigned char* ws = P.ws;
    const float* X1 = (const float*)(ws + WS_X1); const float* MOD = (const float*)(ws + WS_MOD); const bf16_t* YS = (const bf16_t*)(ws + WS_YS);
    const float* TOPW = (const float*)(ws + WS_ROUTE + 256 * 1024); const int* POS = (const int*)(ws + WS_ROUTE + 768 * 1024);
    const int gw = bid * 8 + wave, NGW = G * 8;
    for (int m = gw; m < M; m += NGW) {
        const int b = m >> 13;
        int pos = 0; float wt = 0.f;
        if (lane < 4) { pos = POS[m * 4 + lane]; wt = TOPW[m * 4 + lane]; }
        const f32x4* xr = (const f32x4*)(X1 + (size_t)m * 1024) + lane;
        f32x4 v[4], acc[4];
#pragma unroll
        for (int j = 0; j < 4; ++j) { v[j] = xr[64 * j]; acc[j] = (f32x4){0.f, 0.f, 0.f, 0.f}; }
#pragma unroll
        for (int k = 0; k < 4; ++k) { const int pk = __shfl(pos, k); const float wk = __shfl(wt, k);
#pragma unroll
            for (int j = 0; j < 4; ++j) { const u32x2 y = *(const u32x2*)(YS + (size_t)pk * 1024 + 4 * lane + 256 * j);
                acc[j][0] += wk * bflo(y.x); acc[j][1] += wk * bfhi(y.x); acc[j][2] += wk * bflo(y.y); acc[j][3] += wk * bfhi(y.y); } }
        float ss = 0.f;
#pragma unroll
        for (int j = 0; j < 4; ++j) { const f32x4 g2 = *(const f32x4*)(MOD + b * 6144 + 5120 + 4 * lane + 256 * j); v[j] = v[j] + g2 * acc[j];
            ss += (v[j][0] * v[j][0] + v[j][1] * v[j][1]) + (v[j][2] * v[j][2] + v[j][3] * v[j][3]); }
        const float rstd = 1.0f / sqrtf(wave_sum(ss) * (1.0f / 1024.0f) + RMS_EPS);
#pragma unroll
        for (int j = 0; j < 4; ++j) { const f32x4 fw = *(const f32x4*)(P.final_norm_w + 4 * lane + 256 * j); *((f32x4*)(P.out + (size_t)m * 1024) + lane + 64 * j) = v[j] * rstd * fw; }
    }
}

#ifndef REPMASK
#define REPMASK 0
#endif
#define REPN(i) (((REPMASK >> (i)) & 1) + 1)
__global__ void __launch_bounds__(512, 2) mk_fwd(Params P) {
    extern __shared__ __attribute__((aligned(16))) unsigned char lds_raw[];
    ldsp lds = (ldsp)lds_raw;
    const int tid = threadIdx.x, lane = tid & 63, wave = __builtin_amdgcn_readfirstlane(tid >> 6);
    const int bid = blockIdx.x, G = gridDim.x;
    unsigned char* ws = P.ws;
    for (int u = tid; u < (LDS_BYTES - LDSCTL_OFF) / 4; u += 512) ((LAS unsigned*)(lds + LDSCTL_OFF))[u] = 0u;
    __syncthreads();
    volatile LAS unsigned* MISC = (volatile LAS unsigned*)(lds + MISC_OFF);
    XcdBarrier bar = xcd_barrier_post((unsigned*)(ws + WS_CTL) + CW_BAR, MISC + 8);

#if !defined(PHMASK) || ((PHMASK >> 0) & 1)
    for (int rep_ = 0; rep_ < REPN(0); ++rep_) {
    p0_prologue(P, lds, tid, lane, wave, bid, G);
    }
    xcd_barrier(bar);
#endif
#if !defined(PHMASK) || ((PHMASK >> 1) & 1)
    for (int rep_ = 0; rep_ < REPN(1); ++rep_) {
    p1_norm1(P, lds, tid, lane, wave, bid, G);
    }
    xcd_barrier(bar);
#endif
#if !defined(PHMASK) || ((PHMASK >> 2) & 1)
    {
        pg8::Gemm g{(const pg8::bf16_t*)(ws + WS_H), (const pg8::bf16_t*)(ws + WS_WIN), M, NMAIN, 1024, 0, 0}; pg8::StaticOrder S; S.init(M, NMAIN, G, bid, REPN(2));
        pg8::EpiInProj E{ws, P.b_merge};
        pg8::gemm_phase<pg8::EpiInProj, pg8::StaticOrder, true, true>(lds, g, S, E);
    }
    {
        pg8::Gemm g{(const pg8::bf16_t*)(ws + WS_WV), (const pg8::bf16_t*)(ws + WS_H), 1024, M, 1024, 0, 0}; pg8::StaticOrder S; S.init(1024, M, G, bid, REPN(2));
        pg8::EpiBf16<0> E{(pg8::bf16_t*)(ws + WS_VT), M, nullptr, 0, 0, 1.f};
        pg8::gemm_phase<pg8::EpiBf16<0>, pg8::StaticOrder, true, true>(lds, g, S, E);
    }
    xcd_barrier(bar);
#endif
#if !defined(PHMASK) || ((PHMASK >> 3) & 1)
    for (int rep_ = 0; rep_ < REPN(3); ++rep_) {
    for (int item = bid; item < 512; item += G) kmean_item(P, lds, item, tid);
    for (int u = bid; u < 256; u += G) gla_unit<false>(P, lds, u >> 5, u & 31, tid, lane, wave);
    }
    xcd_barrier(bar);
#endif
#if !defined(PHMASK) || ((PHMASK >> 4) & 1)
    for (int rep_ = 0; rep_ < REPN(4); ++rep_) {
    if (bid * 512 + tid < 131072) gla_scan(P, tid, bid);
    }
    for (int u = bid; u < 512; u += G) moba_select_unit(P, lds, u >> 8, (u >> 5) & 7, u & 31, tid, lane, wave);
    xcd_barrier(bar);
#endif
#if !defined(PHMASK) || ((PHMASK >> 5) & 1)
    {
        moba_item_table(P, lds, lane, wave);
        volatile LAS int* QI = (volatile LAS int*)(lds + QI_OFF);
        const int NATT = ((const LAS int*)(lds + IPFX_OFF))[512]; const int NG = 256 * REPN(13); const int total = NG + NATT * REPN(5);
        for (;;) {
            if (tid == 0) QI[0] = (int)atomicAdd((unsigned*)(ws + WS_CTL) + CW_QHEAD, 1u);
            __syncthreads();
            const int it = __builtin_amdgcn_readfirstlane(QI[0]);
            __syncthreads();
            if (it >= total) break;
            if (it < NG) gla_unit<true>(P, lds, (it & 255) >> 5, it & 31, tid, lane, wave);
            else moba_item(P, lds, (it - NG) % NATT, tid, wave);
        }
    }
    xcd_barrier(bar);
    moba_combine(P, lane, wave, bid, G);
    xcd_barrier(bar);
#endif
#if !defined(PHMASK) || ((PHMASK >> 6) & 1)
    {
        pg8::Gemm g{(const pg8::bf16_t*)(ws + WS_OA), (const pg8::bf16_t*)(ws + WS_WOA), M, 1024, 1024, 0, 0}; pg8::StaticOrder S; S.init(M, 1024, G, bid, REPN(6));
        pg8::EpiT1 E{(const bf16_t*)(ws + WS_GA), (float*)(ws + WS_T1)};
        pg8::gemm_phase<pg8::EpiT1, pg8::StaticOrder, true, true>(lds, g, S, E);
    }
    {
        pg8::Gemm g{(const pg8::bf16_t*)(ws + WS_OB), (const pg8::bf16_t*)(ws + WS_WOB), M, 1024, 1024, 0, 0}; pg8::StaticOrder S; S.init(M, 1024, G, bid, REPN(6));
        pg8::EpiMerge E{(const bf16_t*)(ws + WS_GB), (const float*)(ws + WS_T1), (bf16_t*)(ws + WS_MERGED)};
        pg8::gemm_phase<pg8::EpiMerge, pg8::StaticOrder, true, true>(lds, g, S, E);
    }
    xcd_barrier(bar);
#endif
#if !defined(PHMASK) || ((PHMASK >> 7) & 1)
    {
        pg8::Gemm g{(const pg8::bf16_t*)(ws + WS_MERGED), (const pg8::bf16_t*)(ws + WS_WOUT), M, 1024, 1024, 0, 0}; pg8::StaticOrder S; S.init(M, 1024, G, bid, REPN(7));
        pg8::EpiX1 E{P.x, (const float*)(ws + WS_MOD), (float*)(ws + WS_X1)};
        pg8::gemm_phase<pg8::EpiX1, pg8::StaticOrder, true, true>(lds, g, S, E);
    }
    xcd_barrier(bar);
#endif
#if !defined(PHMASK) || ((PHMASK >> 8) & 1)
    for (int rep_ = 0; rep_ < REPN(8); ++rep_) {
    p8_router(P, lds, tid, lane, wave, bid, G);
    }
    xcd_barrier(bar);
#endif
#if !defined(PHMASK) || ((PHMASK >> 9) & 1)
    for (int rep_ = 0; rep_ < REPN(9); ++rep_) {
    p9_layout(P, lds, tid);
    p9_gather(P, lds, tid, lane, wave, bid, G);
    }
    xcd_barrier(bar);
#endif
#if !defined(PHMASK) || ((PHMASK >> 10) & 1)
    {
        pg8::Gemm g{(const pg8::bf16_t*)(ws + WS_XP), (const pg8::bf16_t*)(ws + WS_WE1), PT_MAX * 256, 2048, 512, SC_H2, SC_WE};
        pg8::GroupedOrder S{8, G, bid, (const LAS int*)(lds + TEXP_OFF), (const LAS int*)(lds + ESTART_OFF), (size_t)2048 * 1024, REPN(10)};
        pg8::EpiMoE1 E{P.b_exp_in, ws + WS_ACT};
        pg8::gemm_phase<pg8::EpiMoE1, pg8::GroupedOrder, true, true, true>(lds, g, S, E);
    }
    xcd_barrier(bar);
#endif
#if !defined(PHMASK) || ((PHMASK >> 11) & 1)
    {
        pg8::Gemm g{(const pg8::bf16_t*)(ws + WS_ACT), (const pg8::bf16_t*)(ws + WS_WE2), PT_MAX * 256, 1024, 512, SC_ACT, SC_WE};
        pg8::GroupedOrder S{4, G, bid, (const LAS int*)(lds + TEXP_OFF), (const LAS int*)(lds + ESTART_OFF), (size_t)1024 * 1024, REPN(11)};
        pg8::EpiMoE2 E{P.b_exp_out, (bf16_t*)(ws + WS_YS)};
        pg8::gemm_phase<pg8::EpiMoE2, pg8::GroupedOrder, true, true, true>(lds, g, S, E);
    }
    xcd_barrier(bar);
#endif
#if !defined(PHMASK) || ((PHMASK >> 12) & 1)
    for (int rep_ = 0; rep_ < REPN(12); ++rep_) {
    p12_final(P, lane, wave, bid, G);
    }
#endif
}

extern "C" void kernel_launch(void* const* d_in, const int* in_sizes, int n_in, void* d_out, int out_size, void* d_ws, size_t ws_size, hipStream_t stream) {
    static int grid = 0;
    if (grid == 0) {
        if (n_in != 21 || in_sizes[0] != M * D || out_size != M * D || ws_size < WS_END) { fprintf(stderr, "kernel_launch: unexpected shapes (n_in %d, in0 %d, out %d, ws %zu); nothing launched\n", n_in, n_in > 0 ? in_sizes[0] : -1, out_size, ws_size); grid = -1; return; }
        int dev = 0, cus = 0, per_cu = 0;
        if (hipGetDevice(&dev) != hipSuccess || hipDeviceGetAttribute(&cus, hipDeviceAttributeMultiprocessorCount, dev) != hipSuccess) { grid = -1; return; }
        if (hipFuncSetAttribute((const void*)mk_fwd, hipFuncAttributeMaxDynamicSharedMemorySize, LDS_BYTES) != hipSuccess) { fprintf(stderr, "kernel_launch: hipFuncSetAttribute failed\n"); grid = -1; return; }
        if (hipOccupancyMaxActiveBlocksPerMultiprocessor(&per_cu, (const void*)mk_fwd, 512, LDS_BYTES) != hipSuccess || per_cu < 1) { fprintf(stderr, "kernel_launch: occupancy query says %d workgroups per CU; nothing launched\n", per_cu); (void)hipGetLastError(); grid = -1; return; }
        grid = cus;
    }
    if (grid < 0) return;
    (void)hipMemsetAsync((char*)d_ws + WS_CTL, 0, CTL_ZERO_BYTES, stream);
    Params p{};
    const float** pp = (const float**)&p;
    for (int i = 0; i < 21; ++i) pp[i] = (const float*)d_in[i];
    p.out = (float*)d_out; p.ws = (unsigned char*)d_ws;
    void* args[] = {&p};
    hipError_t e = hipLaunchCooperativeKernel((const void*)mk_fwd, dim3(grid), dim3(512), args, LDS_BYTES, stream);
    if (e != hipSuccess) fprintf(stderr, "kernel_launch: cooperative launch failed: %s (grid %d)\n", hipGetErrorString(e), grid);
}
```

```cpp
#include <hip/hip_runtime.h>
#include <hip/hip_bf16.h>
#include <cstdio>
#include <cstdint>
#define LAS __attribute__((address_space(3)))
namespace pg8 {
#define PG8_LAS __attribute__((address_space(3)))
typedef unsigned short bf16_t;
typedef short bf16x8 __attribute__((ext_vector_type(8)));
typedef float f32x4 __attribute__((ext_vector_type(4)));
typedef unsigned u32x4 __attribute__((ext_vector_type(4)));
typedef int i32x4_ __attribute__((ext_vector_type(4)));
typedef int i32x8_ __attribute__((ext_vector_type(8)));
constexpr int BM = 256, BK = 64, HALF = 128, HTB = HALF * BK * 2  , STAGE_BYTES = 8 * HTB, NXCD = 8, WGM = 8;

__host__ __device__ __forceinline__ int lds_byte(int r, int c) { const int st = (r >> 4) * 2 + (c >> 5), rr = r & 15, cc = c & 31, ob = rr * 64 + cc * 2; return st * 1024 + (ob ^ (((ob >> 9) & 1) << 5)); }
__host__ __device__ __forceinline__ void stage_rc(int b, int& R, int& C) { const int st = b / 1024, sb = b % 1024, swz = sb ^ (((sb >> 9) & 1) << 5); R = (st >> 1) * 16 + swz / 64; C = (st & 1) * 32 + (swz % 64) / 2; }
__host__ __device__ __forceinline__ int perm32(int rho) { const int n = rho >> 4, i = rho & 15; return 8 * (i >> 2) + 4 * n + (i & 3); }

struct Unit { int pm, pn, e; };
struct Gemm { const bf16_t* A; const bf16_t* Bt; int M, N, K; int sa, sb; };

struct StaticOrder {
    int nM, nN, nwg, G, c, rep;
    __host__ __device__ void init(int M, int N, int G_, int c_, int rep_ = 1) { nM = M / BM; nN = N / BM; nwg = nM * nN; G = G_; c = c_; rep = rep_; }
    __host__ __device__ bool next(int i, Unit& u) const {
        long L = (long)i * G + c; if (L >= (long)nwg * rep) return false; if (L >= nwg) L -= nwg;
        int wgid = (int)L; { const int q = nwg / NXCD, r = nwg % NXCD, xcd = wgid % NXCD, off = wgid / NXCD; wgid = (xcd < r ? xcd * (q + 1) : r * (q + 1) + (xcd - r) * q) + off; }
        const int nig = WGM * nN, gid = wgid / nig, fm = gid * WGM, gsz = (nM - fm) < WGM ? (nM - fm) : WGM;
        u.pm = fm + ((wgid % nig) % gsz); u.pn = (wgid % nig) / gsz; u.e = 0; return true;
    }
    __device__ __forceinline__ const char* baseA(const Gemm& g, const Unit& u, size_t tstep) const { return (const char*)g.A + (size_t)u.pm * tstep; }
    __device__ __forceinline__ const char* baseB(const Gemm& g, const Unit& u, size_t tstep) const { return (const char*)g.Bt + (size_t)u.pn * tstep; }
    __device__ __forceinline__ void a_ready(const Unit&) const {}
    __device__ __forceinline__ void done(const Unit&) const {}
};

__device__ __forceinline__ unsigned cvt_pk_bf16(float lo, float hi) { unsigned r; asm volatile("v_cvt_pk_bf16_f32 %0, %1, %2" : "=v"(r) : "v"(lo), "v"(hi)); return r; }
typedef float f32x2 __attribute__((ext_vector_type(2)));
__device__ __forceinline__ f32x2 gelu_pk(f32x2 v) {
    const f32x2 av = __builtin_elementwise_abs(v), d = av * 0.2316418882f + 1.0f;
    f32x2 t; t.x = __builtin_amdgcn_rcpf(d.x); t.y = __builtin_amdgcn_rcpf(d.y);
    f32x2 q = t * 0.5307027145f + (-0.7265760135f); q = q * t + 0.7107068705f; q = q * t + (-0.142248368f); q = q * t + 0.127414796f; q = q * t;
    const f32x2 s = (v * v) * (-0.72134752044f);
    f32x2 e; e.x = __builtin_amdgcn_exp2f(s.x); e.y = __builtin_amdgcn_exp2f(s.y);
    const f32x2 m = v * (q * e), r = v - m;
    f32x2 o; o.x = v.x < 0.f ? m.x : r.x; o.y = v.y < 0.f ? m.y : r.y; return o;
}

template <int ACT  > struct EpiBf16 {
    static constexpr bool PERM = true, AFTER_DRAIN = false; static_assert(ACT == 0 || ACT == 1, "EpiBf16: ACT is 0 (none) or 1 (gelu_pk)");
    bf16_t* O; int ldc; const float* bias; int split_cols; size_t split_stride; float scale0;
    __device__ __forceinline__ void operator()(const f32x4 (&acc)[2][2][4][2], const Unit& u, int wr, int wc, int fr, int fq) const {
        const int row0 = u.pm * BM + wr * 64 + fr; int colt = u.pn * BM; bf16_t* base = O;
        float sc = 1.f; if (split_cols) { const int t = colt / split_cols; base += (size_t)t * split_stride; colt -= t * split_cols; if (t == 0) sc = scale0; }
        const int col0 = colt + wc * 32 + 8 * fq, bcol0 = u.pn * BM + wc * 32 + 8 * fq;
        f32x4 bv[2][2];
#pragma unroll
        for (int bj = 0; bj < 2; ++bj)
#pragma unroll
            for (int n = 0; n < 2; ++n) bv[bj][n] = bias ? *(const f32x4*)(bias + bcol0 + bj * HALF + 4 * n) : (f32x4){0.f, 0.f, 0.f, 0.f};
#pragma unroll
        for (int ai = 0; ai < 2; ++ai)
#pragma unroll
            for (int m = 0; m < 4; ++m) { bf16_t* rowp = base + (size_t)(row0 + ai * HALF + m * 16) * ldc + col0;
#pragma unroll
                for (int bj = 0; bj < 2; ++bj) { f32x4 v0 = acc[ai][bj][m][0] + bv[bj][0], v1 = acc[ai][bj][m][1] + bv[bj][1];
                    if (ACT == 1) { f32x2 a = gelu_pk((f32x2){v0[0], v0[1]}), b = gelu_pk((f32x2){v0[2], v0[3]}), c = gelu_pk((f32x2){v1[0], v1[1]}), d = gelu_pk((f32x2){v1[2], v1[3]});
                        v0 = (f32x4){a.x, a.y, b.x, b.y}; v1 = (f32x4){c.x, c.y, d.x, d.y}; }
                    v0 = v0 * sc; v1 = v1 * sc; u32x4 w; w.x = cvt_pk_bf16(v0[0], v0[1]); w.y = cvt_pk_bf16(v0[2], v0[3]); w.z = cvt_pk_bf16(v1[0], v1[1]); w.w = cvt_pk_bf16(v1[2], v1[3]);
                    *(u32x4*)(rowp + bj * HALF) = w; } }
    }
};

template <class E, class = void> struct epi_midhook { static constexpr bool value = false; };
template <class E> struct epi_midhook<E, decltype((void)E::MIDHOOK)> { static constexpr bool value = E::MIDHOOK; };
template <class Epi, class Sched, bool ALIGN_EPI = false, bool SP2 = false, bool FP8 = false>
__device__ __forceinline__ void gemm_phase(PG8_LAS unsigned char* lds, const Gemm g, const Sched& S, const Epi& E) {
    int tid_ = threadIdx.x; asm volatile("" : "+v"(tid_));
    const int tid = tid_, wid = __builtin_amdgcn_readfirstlane(tid >> 6), lane = tid & 63, wr = wid >> 2, wc = wid & 3, fr = lane & 15, fq = lane >> 4;
    const int K = g.K, nt = K / BK;
    unsigned voffA[2], voffB[2];
#pragma unroll
    for (int i = 0; i < 2; ++i) { int R, C; stage_rc(tid * 16 + i * 8192, R, C); const int Rb = Epi::PERM ? ((R & ~31) + perm32(R & 31)) : R;
        voffA[i] = (unsigned)(R * K + C) * 2u; voffB[i] = (unsigned)(Rb * K + C) * 2u; }
    const size_t kstep = (size_t)(BK * 2);
    const size_t hstep = (size_t)HALF * K * 2;
    const size_t tstep = 2 * hstep;
    const unsigned ldsw = (unsigned)wid * 1024u;
    const int aoff = lds_byte(wr * 64 + fr, fq * 8), boff = lds_byte(wc * 32 + fr, fq * 8);
#define PG8_SA(b, h) (((b) * 2 + (h)) * HTB)
#define PG8_SB(b, h) ((4 + (b) * 2 + (h)) * HTB)
#define PG8_STAGE(bufoff, gbase, voff) do { _Pragma("unroll") for (int _i = 0; _i < 2; ++_i) \
        __builtin_amdgcn_global_load_lds((const unsigned*)((const char*)(gbase) + (voff)[_i]), (PG8_LAS unsigned*)(lds + (bufoff) + ldsw + _i * 8192), 16, 0, 0); } while (0)
#define PG8_LDA(dst, b, h) do { _Pragma("unroll") for (int m = 0; m < 4; ++m) _Pragma("unroll") for (int k = 0; k < 2; ++k) dst[m][k] = *(const PG8_LAS bf16x8*)(lds + PG8_SA(b, h) + aoff + m * 2048 + k * 1024); } while (0)
#define PG8_LDB(dst, b, h) do { _Pragma("unroll") for (int n = 0; n < 2; ++n) _Pragma("unroll") for (int k = 0; k < 2; ++k) dst[n][k] = *(const PG8_LAS bf16x8*)(lds + PG8_SB(b, h) + boff + n * 2048 + k * 1024); } while (0)
#define PG8_CAT8(x, y) __builtin_shufflevector(__builtin_bit_cast(i32x4_, (x)), __builtin_bit_cast(i32x4_, (y)), 0, 1, 2, 3, 4, 5, 6, 7)
#define PG8_MMA(ai, bj, At, Bt) do { __builtin_amdgcn_s_setprio(1); _Pragma("unroll") for (int m = 0; m < 4; ++m) _Pragma("unroll") for (int n = 0; n < 2; ++n) { \
        if constexpr (FP8) { const i32x8_ b8_ = PG8_CAT8(Bt[n][0], Bt[n][1]), a8_ = PG8_CAT8(At[m][0], At[m][1]); \
            asm volatile("s_nop 1\n\tv_mfma_scale_f32_16x16x128_f8f6f4 %0, %1, %2, %0, %3, %4 op_sel_hi:[0,0,0]" : "+v"(acc[ai][bj][m][n]) : "v"(b8_), "v"(a8_), "v"(g.sb), "v"(g.sa)); } \
        else { _Pragma("unroll") for (int k = 0; k < 2; ++k) acc[ai][bj][m][n] = __builtin_amdgcn_mfma_f32_16x16x32_bf16(Bt[n][k], At[m][k], acc[ai][bj][m][n], 0, 0, 0); } } __builtin_amdgcn_s_setprio(0); } while (0)
#define PG8_WAIT_V(n) asm volatile("s_waitcnt vmcnt(" #n ")" ::: "memory")
#define PG8_WAIT_L(n) asm volatile("s_waitcnt lgkmcnt(" #n ")" ::: "memory")
#define PG8_BAR __builtin_amdgcn_s_barrier()
#define PG8_SCHED __builtin_amdgcn_sched_barrier(0)
    Unit cur, nxt; int ui = 0;
    if (!S.next(0, cur)) return;
    f32x4 acc[2][2][4][2];
#pragma unroll
    for (int a = 0; a < 2; ++a)
#pragma unroll
        for (int b = 0; b < 2; ++b)
#pragma unroll
            for (int m = 0; m < 4; ++m)
#pragma unroll
                for (int n = 0; n < 2; ++n) acc[a][b][m][n] = (f32x4){0.f, 0.f, 0.f, 0.f};
    bf16x8 At[4][2], B0[2][2], B1[2][2];
    const char* cA = S.baseA(g, cur, tstep); const char* cB = S.baseB(g, cur, tstep);
    S.a_ready(cur);
    if constexpr (SP2) {
        PG8_STAGE(PG8_SB(0, 0), cB, voffB); PG8_STAGE(PG8_SB(0, 1), cB + hstep, voffB); PG8_STAGE(PG8_SA(0, 0), cA, voffA); PG8_STAGE(PG8_SA(0, 1), cA + hstep, voffA);
        if (wr == 1) PG8_BAR;
        PG8_WAIT_V(2); PG8_BAR;
        PG8_STAGE(PG8_SB(1, 0), cB + kstep, voffB); PG8_STAGE(PG8_SA(1, 0), cA + kstep, voffA); PG8_STAGE(PG8_SB(1, 1), cB + hstep + kstep, voffB);
        PG8_WAIT_V(6); PG8_BAR;
    } else {
        PG8_STAGE(PG8_SB(0, 0), cB, voffB); PG8_STAGE(PG8_SA(0, 0), cA, voffA); PG8_STAGE(PG8_SB(0, 1), cB + hstep, voffB); PG8_STAGE(PG8_SA(0, 1), cA + hstep, voffA);
        if (wr == 1) PG8_BAR;
        PG8_WAIT_V(4); PG8_BAR;
        PG8_STAGE(PG8_SB(1, 0), cB + kstep, voffB); PG8_STAGE(PG8_SA(1, 0), cA + kstep, voffA); PG8_STAGE(PG8_SB(1, 1), cB + hstep + kstep, voffB);
        PG8_WAIT_V(6); PG8_BAR;
    }
    for (;;) {
        const bool has_next = S.next(ui + 1, nxt);
        const char* nA = has_next ? S.baseA(g, nxt, tstep) : cA; const char* nB = has_next ? S.baseB(g, nxt, tstep) : cB;
        for (int t = 0; t < nt; t += 2) {
            if constexpr (epi_midhook<Epi>::value) { if (t == nt / 2) { __builtin_amdgcn_sched_barrier(0); E.mid(acc, cur, wr, wc, fr, fq); __builtin_amdgcn_sched_barrier(0); } }
            const bool last = (t == nt - 2);
            const char* a1 = cA + (size_t)(t + 1) * kstep;
            const char* a2 = last ? nA : cA + (size_t)(t + 2) * kstep; const char* b2 = last ? nB : cB + (size_t)(t + 2) * kstep;
            const char* a3 = a2 + kstep; const char* b3 = b2 + kstep;
            if (last && has_next) S.a_ready(nxt);
            if constexpr (SP2) {
            PG8_LDB(B0, 0, 0); PG8_LDB(B1, 0, 1); PG8_SCHED; PG8_LDA(At, 0, 0); PG8_STAGE(PG8_SA(1, 1), a1 + hstep, voffA);
            PG8_WAIT_V(8); PG8_WAIT_L(0); PG8_BAR; PG8_MMA(0, 0, At, B0); PG8_MMA(0, 1, At, B1); PG8_BAR; PG8_SCHED;
            PG8_LDA(At, 0, 1); PG8_STAGE(PG8_SB(0, 0), b2, voffB); PG8_STAGE(PG8_SB(0, 1), b2 + hstep, voffB); PG8_STAGE(PG8_SA(0, 0), a2, voffA);
            PG8_WAIT_V(8); PG8_WAIT_L(0); PG8_BAR; PG8_MMA(1, 0, At, B0); PG8_MMA(1, 1, At, B1); PG8_BAR; PG8_SCHED;
            PG8_LDB(B0, 1, 0); PG8_LDB(B1, 1, 1); PG8_SCHED; PG8_LDA(At, 1, 0); PG8_STAGE(PG8_SA(0, 1), a2 + hstep, voffA);
            PG8_WAIT_V(8); PG8_WAIT_L(0); PG8_BAR; PG8_MMA(0, 0, At, B0); PG8_MMA(0, 1, At, B1); PG8_BAR; PG8_SCHED;
            PG8_LDA(At, 1, 1); PG8_STAGE(PG8_SB(1, 0), b3, voffB); PG8_STAGE(PG8_SB(1, 1), b3 + hstep, voffB); PG8_STAGE(PG8_SA(1, 0), a3, voffA);
            PG8_WAIT_V(8); PG8_WAIT_L(0); PG8_BAR; PG8_MMA(1, 0, At, B0); PG8_MMA(1, 1, At, B1); PG8_BAR; PG8_SCHED;
            } else {
            PG8_LDB(B0, 0, 0); PG8_SCHED; PG8_LDA(At, 0, 0); PG8_STAGE(PG8_SA(1, 1), a1 + hstep, voffA);
            PG8_WAIT_L(8); PG8_BAR; PG8_WAIT_L(0); PG8_MMA(0, 0, At, B0); PG8_BAR; PG8_SCHED;
            PG8_LDB(B1, 0, 1); PG8_STAGE(PG8_SB(0, 0), b2, voffB);
            PG8_BAR; PG8_WAIT_L(0); PG8_MMA(0, 1, At, B1); PG8_BAR;
            PG8_LDA(At, 0, 1); PG8_STAGE(PG8_SA(0, 0), a2, voffA);
            PG8_BAR; PG8_WAIT_L(0); PG8_MMA(1, 0, At, B0); PG8_BAR; PG8_SCHED;
            PG8_STAGE(PG8_SB(0, 1), b2 + hstep, voffB);
            PG8_WAIT_V(6); PG8_BAR; PG8_MMA(1, 1, At, B1); PG8_BAR;
            PG8_LDB(B0, 1, 0); PG8_SCHED; PG8_LDA(At, 1, 0); PG8_STAGE(PG8_SA(0, 1), a2 + hstep, voffA);
            PG8_WAIT_L(8); PG8_BAR; PG8_WAIT_L(0); PG8_MMA(0, 0, At, B0); PG8_BAR; PG8_SCHED;
            PG8_LDB(B1, 1, 1); PG8_STAGE(PG8_SB(1, 0), b3, voffB);
            PG8_BAR; PG8_WAIT_L(0); PG8_MMA(0, 1, At, B1); PG8_BAR;
            PG8_LDA(At, 1, 1); PG8_STAGE(PG8_SA(1, 0), a3, voffA);
            PG8_BAR; PG8_WAIT_L(0); PG8_MMA(1, 0, At, B0); PG8_BAR; PG8_SCHED;
            PG8_STAGE(PG8_SB(1, 1), b3 + hstep, voffB);
            PG8_WAIT_V(6); PG8_BAR; PG8_MMA(1, 1, At, B1); PG8_BAR;
            }
        }
        if constexpr (ALIGN_EPI) { if (wr == 0) PG8_BAR; }
        if constexpr (FP8) asm volatile("s_nop 15\n\ts_nop 7" ::: "memory");
        if constexpr (!Epi::AFTER_DRAIN) { E(acc, cur, wr, wc, fr, fq); S.done(cur); }
        if (!has_next) break;
#pragma unroll
        for (int a = 0; a < 2; ++a)
#pragma unroll
            for (int b = 0; b < 2; ++b)
#pragma unroll
                for (int m = 0; m < 4; ++m)
#pragma unroll
                    for (int n = 0; n < 2; ++n) acc[a][b][m][n] = (f32x4){0.f, 0.f, 0.f, 0.f};
        cur = nxt; cA = nA; cB = nB; ++ui;
        if constexpr (ALIGN_EPI) { if (wr == 1) PG8_BAR; }
    }
    PG8_WAIT_V(0);
    if constexpr (!ALIGN_EPI) { if (wr == 0) PG8_BAR; }
    PG8_BAR;
    if constexpr (Epi::AFTER_DRAIN) { E.fused(acc, cur, wr, wc, fr, fq, lds, wid, lane); S.done(cur); }
#undef PG8_SA
#undef PG8_SB
#undef PG8_STAGE
#undef PG8_LDA
#undef PG8_LDB
#undef PG8_MMA
#undef PG8_CAT8
#undef PG8_WAIT_V
#undef PG8_WAIT_L
#undef PG8_BAR
#undef PG8_SCHED
}
}
#define XB_TMO      128
#define XB_XCNT(j)  (256  + 64 * (j))
#define XB_XSUB(j)  (1280 + 64 * (j))
#define XB_XGEN(j)  (2304 + 64 * (j))
#define XB_TOP      3328
#define XB_TOPGEN   3392
#define XCD_BAR_WORDS 3456
#define XB_SPIN_CAP (1u << 18)

__device__ __forceinline__ unsigned xb_ld(unsigned* p)              { return __hip_atomic_load(p, __ATOMIC_RELAXED, __HIP_MEMORY_SCOPE_AGENT); }
__device__ __forceinline__ unsigned xb_add(unsigned* p, unsigned v) { return __hip_atomic_fetch_add(p, v, __ATOMIC_RELAXED, __HIP_MEMORY_SCOPE_AGENT); }
__device__ __forceinline__ unsigned xb_xcc_id() { return (unsigned)__builtin_amdgcn_s_getreg((3 << 11) | 20) & 0xFu; }
#define XB_SPIN(cond, bar) do { unsigned _sp = 0; while (cond) { __builtin_amdgcn_s_sleep(1); \
    if ((++_sp & 255u) == 0u) { if (xb_ld(&(bar)[XB_TMO])) break; if (_sp > XB_SPIN_CAP) { atomicAdd(&(bar)[XB_TMO], 1u); break; } } } } while (0)

struct XcdBarrier {
    unsigned* bar; unsigned x;
    volatile LAS unsigned* st;
};

__device__ __forceinline__ XcdBarrier xcd_barrier_post(unsigned* bar, volatile LAS unsigned* st) {
    XcdBarrier b; b.bar = bar; b.x = xb_xcc_id(); b.st = st;
    if (threadIdx.x == 0) (void)xb_add(&bar[XB_XCNT(b.x)], 1u);
    return b;
}
__device__ __forceinline__ void xcd_barrier_complete(unsigned* bar, unsigned x, unsigned& nloc, unsigned& nx) {
    const unsigned G = gridDim.x * gridDim.y * gridDim.z;
    unsigned sum, cnt, mine, sp = 0u;
    for (;;) {
        sum = 0u; cnt = 0u; mine = 0u;
#pragma unroll
        for (unsigned j = 0; j < 16; ++j) { const unsigned c = xb_ld(&bar[XB_XCNT(j)]); sum += c; cnt += (c > 0u) ? 1u : 0u; mine = (j == x) ? c : mine; }
        if (sum == G) break;
        __builtin_amdgcn_s_sleep(1);
        if ((++sp & 255u) == 0u) { if (xb_ld(&bar[XB_TMO])) break; if (sp > XB_SPIN_CAP) { atomicAdd(&bar[XB_TMO], 1u); break; } }
    }
    nloc = mine > 0u ? mine : 1u; nx = cnt > 0u ? cnt : 1u;
}

__device__ __forceinline__ void xcd_barrier(const XcdBarrier& b) {
    asm volatile("s_waitcnt vmcnt(0)" ::: "memory");
    __syncthreads();
    if (threadIdx.x == 0) {
        unsigned* bar = b.bar;
        __builtin_amdgcn_s_waitcnt(0);
        unsigned nloc = b.st[0], nx = b.st[1];
        if (nloc == 0u) { xcd_barrier_complete(bar, b.x, nloc, nx); b.st[0] = nloc; b.st[1] = nx; }
        const unsigned old = xb_add(&bar[XB_XSUB(b.x)], 1u);
        const unsigned gen = old / nloc;
        if (old + 1u == (gen + 1u) * nloc) {
            __builtin_amdgcn_fence(__ATOMIC_RELEASE, "agent");
            asm volatile("s_waitcnt vmcnt(0)" ::: "memory");
            const unsigned og = xb_add(&bar[XB_TOP], 1u);
            const unsigned tg = og / nx;
            if (og + 1u == (tg + 1u) * nx) xb_add(&bar[XB_TOPGEN], 1u);
            else XB_SPIN(xb_ld(&bar[XB_TOPGEN]) == tg, bar);
            __builtin_amdgcn_fence(__ATOMIC_ACQUIRE, "agent");
            xb_add(&bar[XB_XGEN(b.x)], 1u);
            asm volatile("s_waitcnt vmcnt(0)" ::: "memory");
        } else {
            XB_SPIN(xb_ld(&bar[XB_XGEN(b.x)]) == gen, bar);
            __builtin_amdgcn_fence(__ATOMIC_ACQUIRE, "agent");
            asm volatile("s_waitcnt vmcnt(0)" ::: "memory");
        }
    }
    __syncthreads();
}

typedef LAS unsigned char* ldsp;
typedef unsigned short bf16_t;
typedef short bf16x8 __attribute__((ext_vector_type(8)));
typedef short s16x4 __attribute__((ext_vector_type(4)));
typedef float f32x4 __attribute__((ext_vector_type(4)));
typedef float f32x16 __attribute__((ext_vector_type(16)));
typedef unsigned u32x4 __attribute__((ext_vector_type(4)));
typedef unsigned u32x2 __attribute__((ext_vector_type(2)));
typedef float f32x2_t __attribute__((ext_vector_type(2)));
typedef __bf16 bf16x2_t __attribute__((ext_vector_type(2)));

constexpr int NB = 2, SEQ = 8192, M = NB * SEQ, D = 1024;
constexpr int NIN = 8208, NMAIN = 7168, NEXP = 32;
constexpr int PT_MAX = 288;
constexpr float RMS_EPS = 1e-5f;
constexpr float QK_SCALE = 0.08838834764831845f;
constexpr float C2 = QK_SCALE * 1.4426950408889634f;
constexpr float H2_SCALE = 8.0f, ACT_SCALE = 4.0f, WE_SCALE = 64.0f;
constexpr int SC_H2 = 0x7c7c7c7c, SC_ACT = 0x7d7d7d7d, SC_WE = 0x79797979;

constexpr size_t MiB = 1u << 20;
constexpr size_t WS_CTL = 0, CTL_ZERO_BYTES = 1 * MiB;
constexpr size_t WS_MODP = 1 * MiB;
constexpr size_t WS_MOD = 1 * MiB + 832 * 1024;
constexpr size_t WS_ROPE = 2 * MiB;
constexpr size_t WS_KM = 3 * MiB;
constexpr size_t WS_COEF = 3 * MiB + 512 * 1024;
constexpr size_t WS_DG = 3 * MiB + 640 * 1024;
constexpr size_t WS_ROUTE = 4 * MiB;
constexpr size_t WS_GLOW = 5 * MiB;
constexpr size_t WS_WIN = 8 * MiB, WS_WV = 22 * MiB, WS_WOA = 24 * MiB, WS_WOB = 26 * MiB, WS_WOUT = 28 * MiB;
constexpr size_t WS_WE1 = 32 * MiB, WS_WE2 = 160 * MiB, WS_H = 224 * MiB;
constexpr size_t WS_MQ = 256 * MiB, WS_MK = 288 * MiB, WS_VT = 320 * MiB, WS_GQ = 352 * MiB, WS_GK = 368 * MiB, WS_GV = 384 * MiB, WS_GR = 416 * MiB, WS_GA = 448 * MiB, WS_GB = 480 * MiB;
constexpr size_t WS_OA = 512 * MiB, WS_OB = 544 * MiB, WS_TG = 576 * MiB, WS_GS = 608 * MiB, WS_T1 = 640 * MiB, WS_MERGED = 704 * MiB, WS_X1 = 736 * MiB;
constexpr size_t WS_XP = 256 * MiB, WS_ACT = 400 * MiB, WS_YS = 544 * MiB, WS_END = 800 * MiB;
constexpr int CW_BAR = 4096, CW_CNT = 16384;

constexpr int LDS_BYTES = 163840, LDSCTL_OFF = 157696;
constexpr int MISC_OFF = LDSCTL_OFF;
constexpr int TEXP_OFF = LDSCTL_OFF + 128;
constexpr int ESTART_OFF = TEXP_OFF + 288 * 4;
constexpr int LH_OFF = ESTART_OFF + 40 * 4;
constexpr int LBASE_OFF = LH_OFF + 128;
constexpr int ALIST_OFF = LBASE_OFF + 128;
constexpr int QI_OFF = ALIST_OFF + 160;
constexpr int IPFX_OFF = QI_OFF + 16;
static_assert(IPFX_OFF + 516 * 4 <= LDS_BYTES, "LDS ctl map");

struct Params {
    const float *x, *c, *w_ada, *b_ada, *norm1_w, *w_in, *gla_gate_w, *gla_gate_b, *gla_norm_w, *w_o_moba, *w_o_gla, *b_merge, *w_out, *norm2_w, *w_router, *b_router, *w_exp_in, *b_exp_in, *w_exp_out, *b_exp_out, *final_norm_w;
    float* out; unsigned char* ws;
};

__device__ __forceinline__ unsigned cvtpk(float lo, float hi) { f32x2_t v = {lo, hi}; bf16x2_t b = __builtin_convertvector(v, bf16x2_t); return __builtin_bit_cast(unsigned, b); }
__device__ __forceinline__ unsigned f2bf(float f) { return cvtpk(f, 0.f) & 0xffffu; }
__device__ __forceinline__ float bf2f(unsigned b) { return __uint_as_float(b << 16); }
__device__ __forceinline__ float bflo(unsigned w) { return __uint_as_float(w << 16); }
__device__ __forceinline__ float bfhi(unsigned w) { return __uint_as_float(w & 0xffff0000u); }
__device__ __forceinline__ int crow(int reg, int h) { return (reg & 3) + 8 * (reg >> 2) + 4 * h; }
__device__ __forceinline__ float wave_sum(float v) {
#pragma unroll
    for (int o = 1; o < 64; o <<= 1) v += __shfl_xor(v, o);
    return v;
}
__device__ __forceinline__ float sigmoidf_(float z) { return __builtin_amdgcn_rcpf(1.0f + __expf(-z)); }
#define MFMA32(a, b, c) __builtin_amdgcn_mfma_f32_32x32x16_bf16((a), (b), (c), 0, 0, 0)
template <int S> __device__ __forceinline__ bf16x8 pack8(const f32x16& x) {
    u32x4 p; p.x = cvtpk(x[8 * S + 0], x[8 * S + 1]); p.y = cvtpk(x[8 * S + 2], x[8 * S + 3]); p.z = cvtpk(x[8 * S + 4], x[8 * S + 5]); p.w = cvtpk(x[8 * S + 6], x[8 * S + 7]);
    return __builtin_bit_cast(bf16x8, p);
}
__device__ __forceinline__ bf16x8 cat44(s16x4 lo, s16x4 hi) { return __builtin_shufflevector(lo, hi, 0, 1, 2, 3, 4, 5, 6, 7); }

namespace pg8 {
struct EpiInProj {
    static constexpr bool PERM = true, AFTER_DRAIN = false;
    unsigned char* ws; const float* b_merge;
    __device__ __forceinline__ void operator()(const f32x4 (&acc)[2][2][4][2], const Unit& u, int wr, int wc, int fr, int fq) const {
        const int pn = u.pn; const int row0 = u.pm * BM + wr * 64 + fr; const int cl0 = wc * 32 + 8 * fq;
        bf16_t* dst; int ld = 1024, colt; int mode;
        float osc = 1.f; const float* bias = nullptr;
        if (pn < 4) { dst = (bf16_t*)(ws + WS_MQ); colt = pn * 256; mode = 0; osc = C2; }
        else if (pn < 8) { dst = (bf16_t*)(ws + WS_MK); colt = (pn - 4) * 256; mode = 0; }
        else if (pn < 10) { dst = (bf16_t*)(ws + WS_GQ); ld = 512; colt = (pn - 8) * 256; mode = 1; osc = QK_SCALE; }
        else if (pn < 12) { dst = (bf16_t*)(ws + WS_GK); ld = 512; colt = (pn - 10) * 256; mode = 2; }
        else if (pn < 16) { dst = (bf16_t*)(ws + WS_GV); colt = (pn - 12) * 256; mode = 2; }
        else if (pn < 20) { dst = (bf16_t*)(ws + WS_GR); colt = (pn - 16) * 256; mode = 3; }
        else if (pn < 24) { dst = (bf16_t*)(ws + WS_GA); colt = (pn - 20) * 256; mode = 4; bias = b_merge; }
        else { dst = (bf16_t*)(ws + WS_GB); colt = (pn - 24) * 256; mode = 4; bias = b_merge + 1024; }
        const float* rc = (const float*)(ws + WS_ROPE); const float* rs = rc + SEQ * 16;
        f32x4 bv[2][2];
#pragma unroll
        for (int bj = 0; bj < 2; ++bj)
#pragma unroll
            for (int n = 0; n < 2; ++n) bv[bj][n] = (mode == 4) ? *(const f32x4*)(bias + colt + bj * HALF + cl0 + 4 * n) : (f32x4){0.f, 0.f, 0.f, 0.f};
#pragma unroll
        for (int ai = 0; ai < 2; ++ai)
#pragma unroll
            for (int m = 0; m < 4; ++m) {
                const int row = row0 + ai * HALF + m * 16;
                f32x4 cs0 = {1.f, 1.f, 1.f, 1.f}, cs1 = cs0, sn0 = {0.f, 0.f, 0.f, 0.f}, sn1 = sn0;
                const bool rope = (mode == 0) && (wc == 0);
                if (rope) { const int pos = row & (SEQ - 1); const float* pc = rc + pos * 16 + 8 * (fq & 1); const float* ps = rs + pos * 16 + 8 * (fq & 1);
                    cs0 = *(const f32x4*)pc; cs1 = *(const f32x4*)(pc + 4); sn0 = *(const f32x4*)ps; sn1 = *(const f32x4*)(ps + 4);
                    if (fq < 2) { sn0 = -sn0; sn1 = -sn1; } }
                bf16_t* rowp = dst + (size_t)row * ld + colt + cl0;
#pragma unroll
                for (int bj = 0; bj < 2; ++bj) {
                    f32x4 v0 = acc[ai][bj][m][0], v1 = acc[ai][bj][m][1];
                    if (rope) {
                        f32x4 p0, p1;
#pragma unroll
                        for (int i = 0; i < 4; ++i) { p0[i] = __shfl_xor(v0[i], 32); p1[i] = __shfl_xor(v1[i], 32); }
                        v0 = v0 * cs0 + p0 * sn0; v1 = v1 * cs1 + p1 * sn1;
                    }
                    if (mode <= 1) { v0 = v0 * osc; v1 = v1 * osc; }
                    if (mode == 3) {
#pragma unroll
                        for (int i = 0; i < 4; ++i) { v0[i] = v0[i] * sigmoidf_(v0[i]); v1[i] = v1[i] * sigmoidf_(v1[i]); } }
                    if (mode == 4) { v0 = v0 + bv[bj][0]; v1 = v1 + bv[bj][1];
#pragma unroll
                        for (int i = 0; i < 4; ++i) { v0[i] = sigmoidf_(v0[i]); v1[i] = sigmoidf_(v1[i]); } }
                    u32x4 w; w.x = cvtpk(v0[0], v0[1]); w.y = cvtpk(v0[2], v0[3]); w.z = cvtpk(v1[0], v1[1]); w.w = cvtpk(v1[2], v1[3]);
                    *(u32x4*)(rowp + bj * HALF) = w;
                }
            }
    }
};
struct EpiMerge2 {
    static constexpr bool PERM = true, AFTER_DRAIN = false, MIDHOOK = true;
    const bf16_t* GA; const bf16_t* GB; bf16_t* O;
    __device__ __forceinline__ void mid(f32x4 (&acc)[2][2][4][2], const Unit& u, int wr, int wc, int fr, int fq) const {
        int row0 = u.pm * BM + wr * 64 + fr; asm volatile("" : "+v"(row0));
        const int col0 = u.pn * BM + wc * 32 + 8 * fq;
#pragma unroll
        for (int ai = 0; ai < 2; ++ai)
#pragma unroll
            for (int m = 0; m < 4; ++m) { const size_t off = (size_t)(row0 + ai * HALF + m * 16) * 1024 + col0;
#pragma unroll
                for (int bj = 0; bj < 2; ++bj) { const u32x4 a = *(const u32x4*)(GA + off + bj * HALF), b = *(const u32x4*)(GB + off + bj * HALF);
                    f32x4& v0 = acc[ai][bj][m][0]; f32x4& v1 = acc[ai][bj][m][1];
#define RT(x, y) ((x) * __builtin_amdgcn_rcpf(fmaxf((y), 1e-20f)))
                    v0[0] *= RT(bflo(a.x), bflo(b.x)); v0[1] *= RT(bfhi(a.x), bfhi(b.x)); v0[2] *= RT(bflo(a.y), bflo(b.y)); v0[3] *= RT(bfhi(a.y), bfhi(b.y));
                    v1[0] *= RT(bflo(a.z), bflo(b.z)); v1[1] *= RT(bfhi(a.z), bfhi(b.z)); v1[2] *= RT(bflo(a.w), bflo(b.w)); v1[3] *= RT(bfhi(a.w), bfhi(b.w));
#undef RT
                }
                if (m & 1) asm volatile("" ::: "memory"); }
    }
    __device__ __forceinline__ void operator()(const f32x4 (&acc)[2][2][4][2], const Unit& u, int wr, int wc, int fr, int fq) const {
        int row0 = u.pm * BM + wr * 64 + fr; asm volatile("" : "+v"(row0));
        const int col0 = u.pn * BM + wc * 32 + 8 * fq;
#pragma unroll
        for (int ai = 0; ai < 2; ++ai)
#pragma unroll
            for (int m = 0; m < 4; ++m) { const size_t off = (size_t)(row0 + ai * HALF + m * 16) * 1024 + col0;
#pragma unroll
                for (int bj = 0; bj < 2; ++bj) { const u32x4 g = *(const u32x4*)(GB + off + bj * HALF);
                    const f32x4 v0 = acc[ai][bj][m][0], v1 = acc[ai][bj][m][1];
                    u32x4 w; w.x = cvtpk(v0[0] * bflo(g.x), v0[1] * bfhi(g.x)); w.y = cvtpk(v0[2] * bflo(g.y), v0[3] * bfhi(g.y)); w.z = cvtpk(v1[0] * bflo(g.z), v1[1] * bfhi(g.z)); w.w = cvtpk(v1[2] * bflo(g.w), v1[3] * bfhi(g.w));
                    *(u32x4*)(O + off + bj * HALF) = w; } }
    }
};
struct EpiX1 {
    static constexpr bool PERM = false, AFTER_DRAIN = false;
    const float* x; const float* mod; float* X1;
    __device__ __forceinline__ void operator()(const f32x4 (&acc)[2][2][4][2], const Unit& u, int wr, int wc, int fr, int fq) const {
        const int row0 = u.pm * BM + wr * 64 + fr, col0 = u.pn * BM + wc * 32 + 4 * fq;
        const float* g1 = mod + ((u.pm * BM) >> 13) * 6144 + 2048;
        f32x4 gv[2][2];
#pragma unroll
        for (int bj = 0; bj < 2; ++bj)
#pragma unroll
            for (int n = 0; n < 2; ++n) gv[bj][n] = *(const f32x4*)(g1 + col0 + bj * HALF + n * 16);
#pragma unroll
        for (int ai = 0; ai < 2; ++ai)
#pragma unroll
            for (int m = 0; m < 4; ++m) { const size_t off = (size_t)(row0 + ai * HALF + m * 16) * 1024 + col0;
#pragma unroll
                for (int bj = 0; bj < 2; ++bj)
#pragma unroll
                    for (int n = 0; n < 2; ++n) { const f32x4 xv = *(const f32x4*)(x + off + bj * HALF + n * 16);
                        *(f32x4*)(X1 + off + bj * HALF + n * 16) = xv + gv[bj][n] * acc[ai][bj][m][n]; } }
    }
};
struct EpiMoE1 {
    static constexpr bool PERM = true, AFTER_DRAIN = false;
    const float* b1; unsigned char* ACT;
    __device__ __forceinline__ void operator()(const f32x4 (&acc)[2][2][4][2], const Unit& u, int wr, int wc, int fr, int fq) const {
        const int row0 = u.pm * BM + wr * 64 + fr, col0 = u.pn * BM + wc * 32 + 8 * fq;
        const float* bp = b1 + (size_t)u.e * 2048 + col0;
        f32x4 bv[2][2];
#pragma unroll
        for (int bj = 0; bj < 2; ++bj)
#pragma unroll
            for (int n = 0; n < 2; ++n) bv[bj][n] = *(const f32x4*)(bp + bj * HALF + 4 * n);
#pragma unroll
        for (int ai = 0; ai < 2; ++ai)
#pragma unroll
            for (int m = 0; m < 4; ++m) { unsigned char* rowp = ACT + (size_t)(row0 + ai * HALF + m * 16) * 1024 + (col0 >> 1);
#pragma unroll
                for (int bj = 0; bj < 2; ++bj) { const f32x4 v0 = acc[ai][bj][m][0] + bv[bj][0], v1 = acc[ai][bj][m][1] + bv[bj][1];
                    float o[4];
#pragma unroll
                    for (int q = 0; q < 4; ++q) { const float gl = q < 2 ? v0[2 * q] : v1[2 * q - 4], ln = q < 2 ? v0[2 * q + 1] : v1[2 * q - 3];
                        const float xg = fminf(gl, 7.0f), xl = fminf(fmaxf(ln, -7.0f), 7.0f); o[q] = xg * sigmoidf_(1.702f * xg) * (xl + 1.0f) * ACT_SCALE; }
                    int w = __builtin_amdgcn_cvt_pk_fp8_f32(o[0], o[1], 0, false); w = __builtin_amdgcn_cvt_pk_fp8_f32(o[2], o[3], w, true);
                    *(int*)(rowp + bj * 64) = w; } }
    }
};
struct EpiMoE2 {
    static constexpr bool PERM = true, AFTER_DRAIN = false;
    const float* b2; bf16_t* YS;
    __device__ __forceinline__ void operator()(const f32x4 (&acc)[2][2][4][2], const Unit& u, int wr, int wc, int fr, int fq) const {
        const int row0 = u.pm * BM + wr * 64 + fr, col0 = u.pn * BM + wc * 32 + 8 * fq;
        const float* bp = b2 + (size_t)u.e * 1024 + col0;
        f32x4 bv[2][2];
#pragma unroll
        for (int bj = 0; bj < 2; ++bj)
#pragma unroll
            for (int n = 0; n < 2; ++n) bv[bj][n] = *(const f32x4*)(bp + bj * HALF + 4 * n);
#pragma unroll
        for (int ai = 0; ai < 2; ++ai)
#pragma unroll
            for (int m = 0; m < 4; ++m) { bf16_t* rowp = YS + (size_t)(row0 + ai * HALF + m * 16) * 1024 + col0;
#pragma unroll
                for (int bj = 0; bj < 2; ++bj) { const f32x4 v0 = acc[ai][bj][m][0] + bv[bj][0], v1 = acc[ai][bj][m][1] + bv[bj][1];
                    u32x4 w; w.x = cvtpk(v0[0], v0[1]); w.y = cvtpk(v0[2], v0[3]); w.z = cvtpk(v1[0], v1[1]); w.w = cvtpk(v1[2], v1[3]);
                    *(u32x4*)(rowp + bj * HALF) = w; } }
    }
};
struct GroupedOrder {
    int nN, G, c; const LAS int* texp; const LAS int* estart; size_t ebytes; int rep;
    __device__ __forceinline__ bool next(int i, Unit& u) const {
        const int ntiles = estart[32] >> 8; long L = (long)i * G + c; if (L >= (long)ntiles * nN * rep) return false; if (L >= (long)ntiles * nN) L -= (long)ntiles * nN;
        u.pm = (int)(L / nN); u.pn = (int)(L % nN); u.e = texp[u.pm]; return true;
    }
    __device__ __forceinline__ const char* baseA(const Gemm& g, const Unit& u, size_t tstep) const { return (const char*)g.A + (size_t)u.pm * tstep; }
    __device__ __forceinline__ const char* baseB(const Gemm& g, const Unit& u, size_t tstep) const { return (const char*)g.Bt + (size_t)u.e * ebytes + (size_t)u.pn * tstep; }
    __device__ __forceinline__ void a_ready(const Unit&) const {}
    __device__ __forceinline__ void done(const Unit&) const {}
};
}

__device__ __forceinline__ void transpose_item64(const float* W, int ldw, bf16_t* WT, int K, int nblk, LAS float* scr, int item, int lane) {
    const int kb = item / nblk, nb = item % nblk, k0 = 64 * kb, n0 = 64 * nb;
    const float* src = W + (size_t)(k0 + (lane >> 4)) * ldw + n0 + 4 * (lane & 15);
    f32x4 v[16];
#pragma unroll
    for (int i = 0; i < 16; ++i) v[i] = *(const f32x4*)(src + (size_t)(4 * i) * ldw);
#pragma unroll
    for (int i = 0; i < 16; ++i) { LAS float* d = scr + ((lane >> 4) + 4 * i) * 65 + 4 * (lane & 15); d[0] = v[i][0]; d[1] = v[i][1]; d[2] = v[i][2]; d[3] = v[i][3]; }
    asm volatile("s_waitcnt lgkmcnt(0)" ::: "memory");
    const int c = lane & 7;
#pragma unroll
    for (int j = 0; j < 8; ++j) { const int n = (lane >> 3) + 8 * j; const LAS float* s = scr + (8 * c) * 65 + n;
        u32x4 o; o.x = cvtpk(s[0 * 65], s[1 * 65]); o.y = cvtpk(s[2 * 65], s[3 * 65]); o.z = cvtpk(s[4 * 65], s[5 * 65]); o.w = cvtpk(s[6 * 65], s[7 * 65]);
        *(u32x4*)(WT + (size_t)(n0 + n) * K + k0 + 8 * c) = o; }
    asm volatile("s_waitcnt lgkmcnt(0)" ::: "memory");
}
__device__ __forceinline__ void transpose_item64_f8(const float* W, int ldw, unsigned char* WT8, int K, int nblk, LAS float* scr, int item, int lane, float sc) {
    const int kb = item / nblk, nb = item % nblk, k0 = 64 * kb, n0 = 64 * nb;
    const float* src = W + (size_t)(k0 + (lane >> 4)) * ldw + n0 + 4 * (lane & 15);
    f32x4 v[16];
#pragma unroll
    for (int i = 0; i < 16; ++i) v[i] = *(const f32x4*)(src + (size_t)(4 * i) * ldw);
#pragma unroll
    for (int i = 0; i < 16; ++i) { LAS float* d = scr + ((lane >> 4) + 4 * i) * 65 + 4 * (lane & 15); d[0] = v[i][0]; d[1] = v[i][1]; d[2] = v[i][2]; d[3] = v[i][3]; }
    asm volatile("s_waitcnt lgkmcnt(0)" ::: "memory");
    const int c = lane & 7;
#pragma unroll
    for (int j = 0; j < 8; ++j) { const int n = (lane >> 3) + 8 * j; const LAS float* s = scr + (8 * c) * 65 + n;
        int d0 = __builtin_amdgcn_cvt_pk_fp8_f32(s[0 * 65] * sc, s[1 * 65] * sc, 0, false); d0 = __builtin_amdgcn_cvt_pk_fp8_f32(s[2 * 65] * sc, s[3 * 65] * sc, d0, true);
        int d1 = __builtin_amdgcn_cvt_pk_fp8_f32(s[4 * 65] * sc, s[5 * 65] * sc, 0, false); d1 = __builtin_amdgcn_cvt_pk_fp8_f32(s[6 * 65] * sc, s[7 * 65] * sc, d1, true);
        *(u32x2*)(WT8 + (size_t)(n0 + n) * K + k0 + 8 * c) = (u32x2){(unsigned)d0, (unsigned)d1}; }
    asm volatile("s_waitcnt lgkmcnt(0)" ::: "memory");
}
__device__ __forceinline__ void p0_prologue(const Params& P, ldsp lds, int tid, int lane, int wave, int bid, int G) {
    unsigned char* ws = P.ws;
    LAS float* scr = (LAS float*)(lds + wave * 16640);
    const int gw = bid * 8 + wave, NGW = G * 8;
    constexpr int I_S0 = 16 * 32, I_S1 = 16 * 48, I_S2 = 16 * 32, I_S3 = 16 * 16, I_SQ = 16 * 16, I_E1 = 16 * 32, I_E2 = 16 * 16;
    constexpr int NITEMS = I_S0 + I_S1 + I_S2 + I_S3 + 3 * I_SQ + 32 * I_E1 + 32 * I_E2;
    for (int it = gw; it < NITEMS; it += NGW) {
        int r = it;
        if (r < I_S0) { transpose_item64(P.w_in, NIN, (bf16_t*)(ws + WS_WIN), 1024, 32, scr, r, lane); continue; } r -= I_S0;
        if (r < I_S1) { transpose_item64(P.w_in + 3072, NIN, (bf16_t*)(ws + WS_WIN) + (size_t)2048 * 1024, 1024, 48, scr, r, lane); continue; } r -= I_S1;
        if (r < I_S2) { transpose_item64(P.w_in + 6160, NIN, (bf16_t*)(ws + WS_WIN) + (size_t)5120 * 1024, 1024, 32, scr, r, lane); continue; } r -= I_S2;
        if (r < I_S3) { transpose_item64(P.w_in + 2048, NIN, (bf16_t*)(ws + WS_WV), 1024, 16, scr, r, lane); continue; } r -= I_S3;
        if (r < I_SQ) { transpose_item64(P.w_o_moba, 1024, (bf16_t*)(ws + WS_WOA), 2048, 16, scr, r, lane); continue; } r -= I_SQ;
        if (r < I_SQ) { transpose_item64(P.w_o_gla, 1024, (bf16_t*)(ws + WS_WOA) + 1024, 2048, 16, scr, r, lane); continue; } r -= I_SQ;
        if (r < I_SQ) { transpose_item64(P.w_out, 1024, (bf16_t*)(ws + WS_WOUT), 1024, 16, scr, r, lane); continue; } r -= I_SQ;
        if (r < 32 * I_E1) { const int e = r / I_E1; transpose_item64_f8(P.w_exp_in + (size_t)e * 1024 * 2048, 2048, ws + WS_WE1 + (size_t)e * 2048 * 1024, 1024, 32, scr, r % I_E1, lane, WE_SCALE); continue; } r -= 32 * I_E1;
        { const int e = r / I_E2; transpose_item64_f8(P.w_exp_out + (size_t)e * 1024 * 1024, 1024, ws + WS_WE2 + (size_t)e * 1024 * 1024, 1024, 16, scr, r % I_E2, lane, WE_SCALE); }
    }
    float* MODP = (float*)(ws + WS_MODP);
    for (int it = gw; it < 96 * 16; it += NGW) {
        const int g = it % 96, kc = it / 96, col = 64 * g + lane;
        const float c0 = P.c[64 * kc + lane], c1 = P.c[1024 + 64 * kc + lane];
        const float s0 = c0 * sigmoidf_(c0), s1 = c1 * sigmoidf_(c1);
        const float* wp = P.w_ada + (size_t)(64 * kc) * 6144 + col;
        float a0 = 0.f, a1 = 0.f;
#pragma unroll 16
        for (int kk = 0; kk < 64; ++kk) { const float w = wp[(size_t)kk * 6144]; a0 += __shfl(s0, kk) * w; a1 += __shfl(s1, kk) * w; }
        MODP[(kc * 2 + 0) * 6144 + col] = a0; MODP[(kc * 2 + 1) * 6144 + col] = a1;
    }
    { const int g = bid * 512 + tid;
      if (g < SEQ * 16) { const int pos = g >> 4, j = g & 15; const float inv = powf(500000.0f, -(float)j * (1.0f / 16.0f)); const float ang = (float)pos * inv;
          float* rc = (float*)(ws + WS_ROPE); rc[g] = cosf(ang); rc[SEQ * 16 + g] = sinf(ang); } }
}

__device__ __forceinline__ void p1_norm1(const Params& P, ldsp lds, int tid, int lane, int wave, int bid, int G) {
    unsigned char* ws = P.ws;
    const float* MODP = (const float*)(ws + WS_MODP);
    LAS float* A1 = (LAS float*)lds;
    LAS float* B1 = A1 + 2048;
    LAS float* WL = B1 + 2048;
    for (int idx = tid; idx < 2048; idx += 512) { const int b = idx >> 10, c = idx & 1023;
        float sh = P.b_ada[c], sc = P.b_ada[1024 + c];
#pragma unroll
        for (int kc = 0; kc < 16; ++kc) { sh += MODP[(kc * 2 + b) * 6144 + c]; sc += MODP[(kc * 2 + b) * 6144 + 1024 + c]; }
        A1[idx] = P.norm1_w[c] * (1.0f + sc); B1[idx] = sh; }
    for (int idx = tid; idx < 16384; idx += 512) { const int k = idx >> 4, t = idx & 15; WL[t * 1024 + k] = P.w_in[(size_t)k * NIN + 6144 + t]; }
    { const int g = bid * 512 + tid;
      if (g < 2 * 6144) { const int b = g / 6144, n = g % 6144; float s = P.b_ada[n];
#pragma unroll
          for (int kc = 0; kc < 16; ++kc) s += MODP[(kc * 2 + b) * 6144 + n];
          ((float*)(ws + WS_MOD))[g] = s; }
      else if (g < 2 * 6144 + 2048) { const int q = g - 2 * 6144, b = q >> 10, c = q & 1023; float sh = P.b_ada[3072 + c], sc = P.b_ada[4096 + c];
#pragma unroll
          for (int kc = 0; kc < 16; ++kc) { sh += MODP[(kc * 2 + b) * 6144 + 3072 + c]; sc += MODP[(kc * 2 + b) * 6144 + 4096 + c]; }
          float* CO = (float*)(ws + WS_COEF); CO[(b * 2 + 0) * 1024 + c] = P.norm2_w[c] * (1.0f + sc); CO[(b * 2 + 1) * 1024 + c] = sh; } }
    __syncthreads();
    const int gw = bid * 8 + wave, NGW = G * 8;
    bf16_t* H = (bf16_t*)(ws + WS_H); float* GLOW = (float*)(ws + WS_GLOW);
    for (int m = gw; m < M; m += NGW) {
        const int b = m >> 13;
        const f32x4* xr = (const f32x4*)(P.x + (size_t)m * 1024) + lane;
        f32x4 v[4]; float ss = 0.f;
#pragma unroll
        for (int j = 0; j < 4; ++j) { v[j] = xr[64 * j]; ss += (v[j][0] * v[j][0] + v[j][1] * v[j][1]) + (v[j][2] * v[j][2] + v[j][3] * v[j][3]); }
        const float rstd = 1.0f / sqrtf(wave_sum(ss) * (1.0f / 1024.0f) + RMS_EPS);
#pragma unroll
        for (int j = 0; j < 4; ++j) { const f32x4 a = *(const LAS f32x4*)(A1 + b * 1024 + 4 * lane + 256 * j), bb = *(const LAS f32x4*)(B1 + b * 1024 + 4 * lane + 256 * j);
            v[j] = v[j] * rstd * a + bb;
            u32x2 w; w.x = cvtpk(v[j][0], v[j][1]); w.y = cvtpk(v[j][2], v[j][3]);
            *(u32x2*)(H + (size_t)m * 1024 + 4 * lane + 256 * j) = w; }
        float gl[16];
#pragma unroll
        for (int t = 0; t < 16; ++t) { float a = 0.f;
#pragma unroll
            for (int j = 0; j < 4; ++j) { const f32x4 wv = *(const LAS f32x4*)(WL + t * 1024 + 4 * lane + 256 * j); a += (v[j][0] * wv[0] + v[j][1] * wv[1]) + (v[j][2] * wv[2] + v[j][3] * wv[3]); }
            gl[t] = a; if ((t & 3) == 3) __builtin_amdgcn_sched_barrier(0); }
        float r8[8], r4[4], r2[2], r1;
        { const bool hi = (lane & 32) != 0;
#pragma unroll
          for (int j = 0; j < 8; ++j) { const float snd = hi ? gl[j] : gl[8 + j]; const float rcv = __shfl_xor(snd, 32); r8[j] = (hi ? gl[8 + j] : gl[j]) + rcv; } }
        { const bool hi = (lane & 16) != 0;
#pragma unroll
          for (int j = 0; j < 4; ++j) { const float snd = hi ? r8[j] : r8[4 + j]; const float rcv = __shfl_xor(snd, 16); r4[j] = (hi ? r8[4 + j] : r8[j]) + rcv; } }
        { const bool hi = (lane & 8) != 0;
#pragma unroll
          for (int j = 0; j < 2; ++j) { const float snd = hi ? r4[j] : r4[2 + j]; const float rcv = __shfl_xor(snd, 8); r2[j] = (hi ? r4[2 + j] : r4[j]) + rcv; } }
        { const bool hi = (lane & 4) != 0; const float snd = hi ? r2[0] : r2[1]; const float rcv = __shfl_xor(snd, 4); r1 = (hi ? r2[1] : r2[0]) + rcv; }
        r1 += __shfl_xor(r1, 2); r1 += __shfl_xor(r1, 1);
        if ((lane & 3) == 0) GLOW[(size_t)m * 16 + (lane >> 2)] = r1;
    }
}

__device__ __forceinline__ void kmean_item(const Params& P, ldsp lds, int item, int tid) {
    const int blk = item & 31, bh = item >> 5, b = bh >> 3, hd = bh & 7;
    const bf16_t* MK = (const bf16_t*)(P.ws + WS_MK);
    const int c = tid & 15, rg = tid >> 4;
    float a[8];
#pragma unroll
    for (int j = 0; j < 8; ++j) a[j] = 0.f;
    const bf16_t* src = MK + (size_t)(b * SEQ + blk * 256 + rg * 8) * 1024 + hd * 128 + c * 8;
#pragma unroll
    for (int i = 0; i < 8; ++i) { const u32x4 v = *(const u32x4*)(src + (size_t)i * 1024);
        a[0] += bflo(v.x); a[1] += bfhi(v.x); a[2] += bflo(v.y); a[3] += bfhi(v.y); a[4] += bflo(v.z); a[5] += bfhi(v.z); a[6] += bflo(v.w); a[7] += bfhi(v.w); }
    LAS float* part = (LAS float*)lds;
#pragma unroll
    for (int j = 0; j < 8; ++j) part[rg * 128 + c * 8 + j] = a[j];
    __syncthreads();
    if (tid < 128) { float s = 0.f;
#pragma unroll 8
        for (int g = 0; g < 32; ++g) s += part[g * 128 + tid];
        s *= (1.0f / 256.0f);
        const unsigned hi = f2bf(s); const unsigned lo = f2bf(s - bf2f(hi));
        bf16_t* KMH = (bf16_t*)(P.ws + WS_KM); KMH[item * 128 + tid] = (bf16_t)hi; KMH[16 * 32 * 128 + item * 128 + tid] = (bf16_t)lo; }
    __syncthreads();
}

constexpr int GL_Q = 0;
constexpr int GL_K = 16384;
constexpr int GL_V = 32768;
constexpr int GL_B = 65536;
constexpr int GL_GLOW = 98304;
constexpr int GL_CS = 102400;
constexpr int GL_BL = 104448;
constexpr int GL_RS = 104960;
typedef short v4i16_t __attribute__((ext_vector_type(4)));
__device__ __forceinline__ unsigned offb(unsigned row, unsigned ch) { return 256u * row + 16u * (ch ^ (((row & 3u) << 2) | ((row >> 2) & 3u))); }
__device__ __forceinline__ s16x4 trread(ldsp img, int lane, int R0, int c) {
    const unsigned blk = (lane >> 4) & 1, q = (lane & 15) >> 2, p = lane & 3;
    const unsigned a = offb((unsigned)R0 + q, 4u * (unsigned)c + 2u * blk + (p >> 1)) + 8u * (p & 1);
    return __builtin_amdgcn_ds_read_tr16_b64_v4i16((LAS v4i16_t*)(img + a));
}
__device__ __forceinline__ void gla_prep(const Params& P, ldsp lds, int tok0, int hg, bool need_q, int tid) {
    const unsigned char* ws = P.ws;
    u32x4 kraw[2], qraw[2], vraw[4];
    { const bf16_t* GK = (const bf16_t*)(ws + WS_GK) + (size_t)tok0 * 512 + 128 * hg; const bf16_t* GQ = (const bf16_t*)(ws + WS_GQ) + (size_t)tok0 * 512 + 128 * hg;
      const bf16_t* GV = (const bf16_t*)(ws + WS_GV) + (size_t)tok0 * 1024 + 256 * hg;
#pragma unroll
      for (int i = 0; i < 2; ++i) { const int p = tid + 512 * i; kraw[i] = *(const u32x4*)(GK + (size_t)(p >> 4) * 512 + 8 * (p & 15)); if (need_q) qraw[i] = *(const u32x4*)(GQ + (size_t)(p >> 4) * 512 + 8 * (p & 15)); }
#pragma unroll
      for (int i = 0; i < 4; ++i) { const int p = tid + 512 * i; vraw[i] = *(const u32x4*)(GV + (size_t)(p >> 5) * 1024 + 8 * (p & 31)); } }
    if (tid < 256) { const f32x4 v = *(const f32x4*)((const float*)(ws + WS_GLOW) + (size_t)tok0 * 16 + tid * 4); *(LAS f32x4*)(lds + GL_GLOW + tid * 16) = v; }
    const int d = tid & 127, rq = tid >> 7;
    float gw[16];
#pragma unroll
    for (int t = 0; t < 16; ++t) gw[t] = P.gla_gate_w[t * 512 + 128 * hg + d];
    const float gb = P.gla_gate_b[128 * hg + d];
    __syncthreads();
    float bl[16]; float run = 0.f;
    const LAS float* glw = (const LAS float*)(lds + GL_GLOW);
#pragma unroll
    for (int i = 0; i < 16; ++i) { const int row = 16 * rq + i; float z = gb;
#pragma unroll
        for (int t4 = 0; t4 < 4; ++t4) { const f32x4 gv = *(const LAS f32x4*)(glw + row * 16 + 4 * t4); z += gv[0] * gw[4 * t4] + gv[1] * gw[4 * t4 + 1] + gv[2] * gw[4 * t4 + 2] + gv[3] * gw[4 * t4 + 3]; }
        const float ls = fminf(z, 0.f) - __logf(1.0f + __expf(-fabsf(z)));
        run += ls * (1.0f / 16.0f); bl[i] = run; }
    LAS float* CS = (LAS float*)(lds + GL_CS);
    CS[rq * 128 + d] = run;
    __syncthreads();
    float pre = 0.f, tot = 0.f;
#pragma unroll
    for (int q = 0; q < 4; ++q) { const float c = CS[q * 128 + d]; tot += c; if (q < rq) pre += c; }
    if (rq == 0) ((LAS float*)(lds + GL_BL))[d] = tot;
    LAS float* BI = (LAS float*)(lds + GL_B);
#pragma unroll
    for (int i = 0; i < 16; ++i) BI[(16 * rq + i) * 128 + d] = pre + bl[i];
    __syncthreads();
    const LAS float* BL = (const LAS float*)(lds + GL_BL);
#pragma unroll
    for (int i = 0; i < 2; ++i) { const int p = tid + 512 * i, row = p >> 4, ch = p & 15;
        const f32x4 b0 = *(const LAS f32x4*)(BI + row * 128 + 8 * ch), b1 = *(const LAS f32x4*)(BI + row * 128 + 8 * ch + 4), t0 = *(const LAS f32x4*)(BL + 8 * ch), t1 = *(const LAS f32x4*)(BL + 8 * ch + 4);
        float e[8];
#pragma unroll
        for (int j = 0; j < 4; ++j) { e[j] = __expf(t0[j] - b0[j]); e[4 + j] = __expf(t1[j] - b1[j]); }
        const u32x4 k = kraw[i]; u32x4 w;
        w.x = cvtpk(bflo(k.x) * e[0], bfhi(k.x) * e[1]); w.y = cvtpk(bflo(k.y) * e[2], bfhi(k.y) * e[3]); w.z = cvtpk(bflo(k.z) * e[4], bfhi(k.z) * e[5]); w.w = cvtpk(bflo(k.w) * e[6], bfhi(k.w) * e[7]);
        *(LAS u32x4*)(lds + GL_K + offb(row, ch)) = w;
        if (need_q) { const u32x4 q = qraw[i]; u32x4 wq;
            wq.x = cvtpk(bflo(q.x) / e[0], bfhi(q.x) / e[1]); wq.y = cvtpk(bflo(q.y) / e[2], bfhi(q.y) / e[3]); wq.z = cvtpk(bflo(q.z) / e[4], bfhi(q.z) / e[5]); wq.w = cvtpk(bflo(q.w) / e[6], bfhi(q.w) / e[7]);
            *(LAS u32x4*)(lds + GL_Q + offb(row, ch)) = wq; } }
#pragma unroll
    for (int i = 0; i < 4; ++i) { const int p = tid + 512 * i, row = p >> 5, c32 = p & 31; *(LAS u32x4*)(lds + GL_V + (c32 >> 4) * 16384 + offb(row, c32 & 15)) = vraw[i]; }
    __syncthreads();
}
template <bool PHASE_C>
__device__ __forceinline__ void gla_unit(const Params& P, ldsp lds, int bh8, int g, int tid_in, int lane_in, int wave) {
    unsigned char* ws = P.ws;
    const int b = bh8 >> 2, hg = bh8 & 3;
    int tid = tid_in, lane = lane_in; int r = lane & 31, h = lane >> 5;
    f32x16 S[4];
    float* GS = (float*)(ws + WS_GS) + (size_t)(bh8 * 32 + g) * 128 * 256;
#pragma unroll
    for (int dkb = 0; dkb < 4; ++dkb)
#pragma unroll
        for (int reg = 0; reg < 16; ++reg) S[dkb][reg] = PHASE_C ? GS[(size_t)(32 * dkb + crow(reg, h)) * 256 + 32 * wave + r] : 0.f;
    float bsum = 0.f;
    const LAS float* BL = (const LAS float*)(lds + GL_BL);
    const ldsp vimg = lds + GL_V + (wave >> 2) * 16384; const int vc = wave & 3;
    for (int ch = 0; ch < 4; ++ch) {
        tid = tid_in; asm volatile("" : "+v"(tid)); lane = tid & 63; r = lane & 31; h = lane >> 5;
        const int tok0 = b * SEQ + (g * 4 + ch) * 64;
        gla_prep(P, lds, tok0, hg, PHASE_C, tid);
#pragma unroll
        for (int dkb = 0; dkb < 4; ++dkb)
#pragma unroll
            for (int reg = 0; reg < 16; ++reg) S[dkb][reg] *= __expf(BL[32 * dkb + crow(reg, h)]);
        if (tid < 128) bsum += BL[tid];
        __builtin_amdgcn_sched_barrier(0);
        if (PHASE_C) {
            f32x16 at00, at01, at11;
#pragma unroll
            for (int i = 0; i < 16; ++i) { at00[i] = 0.f; at01[i] = 0.f; at11[i] = 0.f; }
#pragma unroll
            for (int s = 0; s < 8; ++s) {
                const unsigned a0 = offb(r, 2 * s + h), a1 = offb(32 + r, 2 * s + h);
                const bf16x8 ka0 = *(const LAS bf16x8*)(lds + GL_K + a0), ka1 = *(const LAS bf16x8*)(lds + GL_K + a1);
                const bf16x8 qb0 = *(const LAS bf16x8*)(lds + GL_Q + a0), qb1 = *(const LAS bf16x8*)(lds + GL_Q + a1);
                at00 = MFMA32(ka0, qb0, at00); at01 = MFMA32(ka0, qb1, at01); at11 = MFMA32(ka1, qb1, at11);
                if (s & 1) __builtin_amdgcn_sched_barrier(0);
            }
#pragma unroll
            for (int reg = 0; reg < 16; ++reg) { if (crow(reg, h) > r) { at00[reg] = 0.f; at11[reg] = 0.f; } }
            f32x16 ot0, ot1;
#pragma unroll
            for (int i = 0; i < 16; ++i) { ot0[i] = 0.f; ot1[i] = 0.f; }
#pragma unroll
            for (int dkb = 0; dkb < 4; ++dkb) {
                const bf16x8 sa0 = pack8<0>(S[dkb]), sa1 = pack8<1>(S[dkb]);
#pragma unroll
                for (int s = 0; s < 2; ++s) {
                    const unsigned chq = 4 * dkb + 2 * s;
                    const bf16x8 q0 = cat44(*(const LAS s16x4*)(lds + GL_Q + offb(r, chq) + 8 * h), *(const LAS s16x4*)(lds + GL_Q + offb(r, chq + 1) + 8 * h));
                    const bf16x8 q1 = cat44(*(const LAS s16x4*)(lds + GL_Q + offb(32 + r, chq) + 8 * h), *(const LAS s16x4*)(lds + GL_Q + offb(32 + r, chq + 1) + 8 * h));
                    ot0 = MFMA32(s == 0 ? sa0 : sa1, q0, ot0); ot1 = MFMA32(s == 0 ? sa0 : sa1, q1, ot1);
                }
                __builtin_amdgcn_sched_barrier(0);
            }
            {
                const bf16x8 p00a = pack8<0>(at00), p00b = pack8<1>(at00), p01a = pack8<0>(at01), p01b = pack8<1>(at01), p11a = pack8<0>(at11), p11b = pack8<1>(at11);
#pragma unroll
                for (int s = 0; s < 2; ++s) {
                    const bf16x8 v0 = cat44(trread(vimg, lane, 16 * s + 4 * h, vc), trread(vimg, lane, 16 * s + 4 * h + 8, vc));
                    const bf16x8 v1 = cat44(trread(vimg, lane, 32 + 16 * s + 4 * h, vc), trread(vimg, lane, 32 + 16 * s + 4 * h + 8, vc));
                    ot0 = MFMA32(v0, s == 0 ? p00a : p00b, ot0);
                    ot1 = MFMA32(v0, s == 0 ? p01a : p01b, ot1);
                    ot1 = MFMA32(v1, s == 0 ? p11a : p11b, ot1);
                }
            }
            __builtin_amdgcn_sched_barrier(0);
            LAS float* RS = (LAS float*)(lds + GL_RS);
            float q0 = 0.f, q1 = 0.f;
#pragma unroll
            for (int i = 0; i < 16; ++i) { q0 += ot0[i] * ot0[i]; q1 += ot1[i] * ot1[i]; }
            q0 += __shfl_xor(q0, 32); q1 += __shfl_xor(q1, 32);
            if (h == 0) { RS[wave * 64 + r] = q0; RS[wave * 64 + 32 + r] = q1; }
            __syncthreads();
            float t0 = 0.f, t1 = 0.f;
#pragma unroll
            for (int w = 0; w < 8; ++w) { t0 += RS[w * 64 + r]; t1 += RS[w * 64 + 32 + r]; }
            const float rs0 = 1.0f / sqrtf(t0 * (1.0f / 256.0f) + RMS_EPS), rs1 = 1.0f / sqrtf(t1 * (1.0f / 256.0f) + RMS_EPS);
            const bf16_t* GR = (const bf16_t*)(ws + WS_GR); bf16_t* OB = (bf16_t*)(ws + WS_OA) + 1024;
#pragma unroll
            for (int ib = 0; ib < 2; ++ib) {
                const size_t rowoff = (size_t)(tok0 + 32 * ib + r) * 1024 + 256 * hg + 32 * wave, rowoff2 = rowoff + (size_t)(tok0 + 32 * ib + r) * 1024;
#pragma unroll
                for (int rq = 0; rq < 4; ++rq) { const int dvl = 8 * rq + 4 * h;
                    const u32x2 gr = *(const u32x2*)(GR + rowoff + dvl);
                    const f32x4 nw = *(const f32x4*)(P.gla_norm_w + 32 * wave + dvl);
                    const float rs = ib == 0 ? rs0 : rs1;
                    float o[4];
#pragma unroll
                    for (int i = 0; i < 4; ++i) o[i] = (ib == 0 ? ot0[4 * rq + i] : ot1[4 * rq + i]) * rs * nw[i];
                    o[0] *= bflo(gr.x); o[1] *= bfhi(gr.x); o[2] *= bflo(gr.y); o[3] *= bfhi(gr.y);
                    u32x2 w; w.x = cvtpk(o[0], o[1]); w.y = cvtpk(o[2], o[3]);
                    *(u32x2*)(OB + rowoff2 + dvl) = w; }
            }
        }
        __builtin_amdgcn_sched_barrier(0);
#pragma unroll
        for (int s = 0; s < 4; ++s) {
            const bf16x8 vb = cat44(trread(vimg, lane, 16 * s + 8 * h, vc), trread(vimg, lane, 16 * s + 8 * h + 4, vc));
#pragma unroll
            for (int dkb = 0; dkb < 4; ++dkb) { const bf16x8 ka = cat44(trread(lds + GL_K, lane, 16 * s + 8 * h, dkb), trread(lds + GL_K, lane, 16 * s + 8 * h + 4, dkb)); S[dkb] = MFMA32(ka, vb, S[dkb]); }
            __builtin_amdgcn_sched_barrier(0);
        }
        __syncthreads();
    }
    if (!PHASE_C) {
        float* TG = (float*)(ws + WS_TG) + (size_t)(bh8 * 32 + g) * 128 * 256;
#pragma unroll
        for (int dkb = 0; dkb < 4; ++dkb)
#pragma unroll
            for (int reg = 0; reg < 16; ++reg) TG[(size_t)(32 * dkb + crow(reg, h)) * 256 + 32 * wave + r] = S[dkb][reg];
        if (tid < 128) ((float*)(ws + WS_DG))[(bh8 * 32 + g) * 128 + tid] = __expf(bsum);
    }
}
__device__ __forceinline__ void gla_scan(const Params& P, int tid, int bid) {
    const float* TG = (const float*)(P.ws + WS_TG); const float* DG = (const float*)(P.ws + WS_DG); float* GS = (float*)(P.ws + WS_GS);
#pragma unroll 1
    for (int rep = 0; rep < 2; ++rep) {
        const int e = bid * 512 + tid + rep * 131072; const int bh8 = e >> 15, dk = (e >> 8) & 127, dv = e & 255;
        const size_t off0 = ((size_t)(bh8 * 32) * 128 + dk) * 256 + dv;
        float tg[32], dg[32];
#pragma unroll
        for (int g = 0; g < 32; ++g) { tg[g] = TG[off0 + (size_t)g * 128 * 256]; dg[g] = DG[(bh8 * 32 + g) * 128 + dk]; }
        float G = 0.f;
#pragma unroll
        for (int g = 0; g < 32; ++g) { GS[off0 + (size_t)g * 128 * 256] = G; G = dg[g] * G + tg[g]; }
    }
}

constexpr size_t WS_PART = 640 * MiB;
constexpr size_t WS_ML = 768 * MiB;
constexpr size_t WS_LIST = 772 * MiB;
constexpr int CW_LCNT = 32768;
constexpr int CW_QHEAD = 40960;
constexpr int AT2_K = 0;
constexpr int AT2_V = 69632;
__device__ __forceinline__ void moba_select_unit(const Params& P, ldsp lds, int b, int hd, int blk, int tid, int lane, int wave) {
    unsigned char* ws = P.ws;
    const int r = lane & 31, h = lane >> 5, bh = b * 8 + hd;
    LAS int* HB = (LAS int*)lds; LAS int* GBASE = HB + 32;
    if (tid < 32) HB[tid] = 0;
    unsigned sel = 0u;
    if (blk > 0) {
        const bf16_t* MQ = (const bf16_t*)(ws + WS_MQ);
        const int tokq = b * SEQ + 256 * blk + 32 * wave + r;
        bf16x8 qr[8];
#pragma unroll
        for (int s = 0; s < 8; ++s) qr[s] = *(const bf16x8*)(MQ + (size_t)tokq * 1024 + 128 * hd + 16 * s + 8 * h);
        const bf16_t* KMH = (const bf16_t*)(ws + WS_KM) + (size_t)(bh * 32 + r) * 128; const bf16_t* KML = KMH + 16 * 32 * 128;
        f32x16 gt;
#pragma unroll
        for (int i = 0; i < 16; ++i) gt[i] = 0.f;
#pragma unroll
        for (int s = 0; s < 8; ++s) { const bf16x8 a = *(const bf16x8*)(KMH + 16 * s + 8 * h), a2 = *(const bf16x8*)(KML + 16 * s + 8 * h); gt = MFMA32(a, qr[s], gt); gt = MFMA32(a2, qr[s], gt); }
#pragma unroll
        for (int round = 0; round < 3; ++round) {
            float best = -INFINITY; int bn = 64;
#pragma unroll
            for (int reg = 0; reg < 16; ++reg) { const int n = crow(reg, h); const bool ok = (n < blk) && !((sel >> n) & 1u); if (ok && gt[reg] > best) { best = gt[reg]; bn = n; } }
            const float ob = __shfl_xor(best, 32); const int on = __shfl_xor(bn, 32);
            if (ob > best || (ob == best && on < bn)) { best = ob; bn = on; }
            if (bn < 64) sel |= 1u << bn;
        }
    }
    __syncthreads();
    int pn[3] = {0, 0, 0}, pr[3] = {0, 0, 0}; int nsel = 0;
    if (h == 0) { unsigned mm = sel;
#pragma unroll
        for (int s = 0; s < 3; ++s) if (mm) { const int n = __builtin_ctz(mm); mm &= mm - 1; pn[s] = n; pr[s] = __hip_atomic_fetch_add(HB + n, 1, __ATOMIC_RELAXED, __HIP_MEMORY_SCOPE_WORKGROUP); nsel = s + 1; } }
    __syncthreads();
    if (tid < 32) { const int c = HB[tid]; if (c > 0) GBASE[tid] = (int)atomicAdd((unsigned*)(ws + WS_CTL) + CW_LCNT + bh * 32 + tid, (unsigned)c); }
    __syncthreads();
    if (h == 0) { const int ql = 256 * blk + 32 * wave + r; unsigned* LIST = (unsigned*)(ws + WS_LIST); float* ML = (float*)(ws + WS_ML);
#pragma unroll
        for (int s = 0; s < 3; ++s) {
            if (s < nsel) LIST[(size_t)(bh * 32 + pn[s]) * 8192 + GBASE[pn[s]] + pr[s]] = (unsigned)ql | ((unsigned)s << 13);
            else { const size_t mi = ((size_t)(bh * 8192 + ql) * 4 + s) * 2; ML[mi] = -1e30f; ML[mi + 1] = 0.f; } } }
    __syncthreads();
}
__device__ __forceinline__ void moba_item_table(const Params& P, ldsp lds, int lane, int wave) {
    LAS int* IPFX = (LAS int*)(lds + IPFX_OFF);
    if (wave == 0) { const unsigned* LC = (const unsigned*)(P.ws + WS_CTL) + CW_LCNT;
        int v[8]; int s = 0;
#pragma unroll
        for (int j = 0; j < 8; ++j) { const int o = lane * 8 + j; const int cnt = (int)__hip_atomic_load(LC + (o & 15) * 32 + (o >> 4), __ATOMIC_RELAXED, __HIP_MEMORY_SCOPE_AGENT);
            const int nch = 1 + ((cnt + 255) >> 8); v[j] = (nch + 3) >> 2; s += v[j]; }
        int incl = s;
#pragma unroll
        for (int o = 1; o < 64; o <<= 1) { const int t = __shfl_up(incl, o); if (lane >= o) incl += t; }
        int excl = incl - s;
#pragma unroll
        for (int j = 0; j < 8; ++j) { IPFX[lane * 8 + j] = excl; excl += v[j]; }
        if (lane == 63) IPFX[512] = incl; }
    __syncthreads();
}
__device__ __forceinline__ void moba_item(const Params& P, ldsp lds, int ia, int tid_in, int wave) {
    unsigned char* ws = P.ws;
    const LAS int* IPFX = (const LAS int*)(lds + IPFX_OFF);
    int lo = 0, hi = 512;
    while (hi - lo > 1) { const int mid = (lo + hi) >> 1; if (IPFX[mid] <= ia) lo = mid; else hi = mid; }
    const int o_ = __builtin_amdgcn_readfirstlane(lo);
    const int n = o_ >> 4, bh = o_ & 15, b = bh >> 3, hd = bh & 7;
    const int cnt = __builtin_amdgcn_readfirstlane((int)__hip_atomic_load((const unsigned*)(ws + WS_CTL) + CW_LCNT + bh * 32 + n, __ATOMIC_RELAXED, __HIP_MEMORY_SCOPE_AGENT));
    const int nch = 1 + ((cnt + 255) >> 8); const int c0 = 4 * (ia - IPFX[o_]); const int c1 = (c0 + 4 < nch) ? c0 + 4 : nch;
    const bf16_t* MQ = (const bf16_t*)(ws + WS_MQ);
    {
        int tid = tid_in; asm volatile("" : "+v"(tid));
        const bf16_t* Kg = (const bf16_t*)(ws + WS_MK) + (size_t)(b * SEQ + 256 * n) * 1024 + 128 * hd;
        const bf16_t* Vg = (const bf16_t*)(ws + WS_VT) + (size_t)(128 * hd) * M + (size_t)b * SEQ + 256 * n;
#pragma unroll
        for (int hf = 0; hf < 2; ++hf) {
            u32x4 kv[4], vv[4];
#pragma unroll
            for (int i = 0; i < 4; ++i) { const int p = tid + 512 * (4 * hf + i); kv[i] = *(const u32x4*)(Kg + (size_t)(p >> 4) * 1024 + 8 * (p & 15)); vv[i] = *(const u32x4*)(Vg + (size_t)(p >> 5) * M + 8 * (p & 31)); }
#pragma unroll
            for (int i = 0; i < 4; ++i) { const int p = tid + 512 * (4 * hf + i);
                *(LAS u32x4*)(lds + AT2_K + (p >> 4) * 272 + 16 * (p & 15)) = kv[i];
                *(LAS u32x2*)(lds + AT2_V + (p >> 5) * 520 + 16 * (p & 31)) = (u32x2){vv[i].x, vv[i].y}; *(LAS u32x2*)(lds + AT2_V + (p >> 5) * 520 + 16 * (p & 31) + 8) = (u32x2){vv[i].z, vv[i].w}; }
        }
    }
    __syncthreads();
    for (int c = c0; c < c1; ++c) {
        int tid = tid_in; asm volatile("" : "+v"(tid)); const int lane = tid & 63, r = lane & 31, h = lane >> 5;
        const bool own = (c == 0);
        const int idx0 = (c - 1) * 256 + 32 * wave;
        if (!own && idx0 >= cnt) continue;
        int ql, slot; bool valid = true;
        if (own) { ql = 256 * n + 32 * wave + r; slot = 3; }
        else { const int idx = idx0 + r; valid = idx < cnt; const unsigned e = ((const unsigned*)(ws + WS_LIST))[(size_t)(bh * 32 + n) * 8192 + (valid ? idx : cnt - 1)]; ql = (int)(e & 8191u); slot = (int)(e >> 13); }
        bf16x8 qr[8];
        { const bf16_t* qp = MQ + (size_t)(b * SEQ + ql) * 1024 + 128 * hd + 8 * h;
#pragma unroll
          for (int s = 0; s < 8; ++s) qr[s] = *(const bf16x8*)(qp + 16 * s); }
        f32x16 o[4];
#pragma unroll
        for (int db = 0; db < 4; ++db)
#pragma unroll
            for (int i = 0; i < 16; ++i) o[db][i] = 0.f;
        float mrun = -1e30f, lrun = 0.f;
        const int tmax = own ? ((32 * wave + 31) >> 6) : 3;
        for (int t = 0; t <= tmax; ++t) {
            f32x16 p0, p1;
#pragma unroll
            for (int i = 0; i < 16; ++i) { p0[i] = 0.f; p1[i] = 0.f; }
            const int krow = AT2_K + (64 * t + r) * 272 + 16 * h;
#pragma unroll
            for (int s = 0; s < 8; ++s) {
                const bf16x8 ka = *(const LAS bf16x8*)(lds + krow + 32 * s), kb = *(const LAS bf16x8*)(lds + krow + 32 * 272 + 32 * s);
                p0 = MFMA32(ka, qr[s], p0); p1 = MFMA32(kb, qr[s], p1);
            }
            if (own) { const int qloc = 32 * wave + r;
#pragma unroll
                for (int reg = 0; reg < 16; ++reg) { const int kl = 64 * t + crow(reg, h); if (kl > qloc) p0[reg] = -INFINITY; if (kl + 32 > qloc) p1[reg] = -INFINITY; } }
            float tm = fmaxf(p0[0], p1[0]);
#pragma unroll
            for (int reg = 1; reg < 16; ++reg) tm = fmaxf(tm, fmaxf(p0[reg], p1[reg]));
            tm = fmaxf(tm, __shfl_xor(tm, 32));
            const float mnew = fmaxf(mrun, tm);
            const float f = __builtin_amdgcn_exp2f(mrun - mnew);
            mrun = mnew;
            float ps = 0.f;
#pragma unroll
            for (int reg = 0; reg < 16; ++reg) { p0[reg] = __builtin_amdgcn_exp2f(p0[reg] - mnew); p1[reg] = __builtin_amdgcn_exp2f(p1[reg] - mnew); ps += p0[reg] + p1[reg]; }
            lrun = lrun * f + ps;
            if (!__all(f == 1.0f)) {
#pragma unroll
                for (int db = 0; db < 4; ++db)
#pragma unroll
                    for (int i = 0; i < 16; ++i) o[db][i] *= f; }
            const bf16x8 pf0 = pack8<0>(p0), pf1 = pack8<1>(p0), pf2 = pack8<0>(p1), pf3 = pack8<1>(p1);
#pragma unroll
            for (int db = 0; db < 4; ++db) {
                const int vrow = AT2_V + (32 * db + r) * 520 + (64 * t + 4 * h) * 2;
#pragma unroll
                for (int ks = 0; ks < 4; ++ks) {
                    const bf16x8 vf = cat44(*(const LAS s16x4*)(lds + vrow + 32 * ks), *(const LAS s16x4*)(lds + vrow + 32 * ks + 16));
                    o[db] = MFMA32(vf, ks == 0 ? pf0 : ks == 1 ? pf1 : ks == 2 ? pf2 : pf3, o[db]);
                }
            }
        }
        lrun += __shfl_xor(lrun, 32);
        const float inv = 1.0f / lrun;
        if (valid) {
            const size_t pi = (size_t)(bh * 8192 + ql) * 4 + slot;
            bf16_t* PO = (bf16_t*)(ws + WS_PART) + pi * 128;
#pragma unroll
            for (int db = 0; db < 4; ++db)
#pragma unroll
                for (int rq = 0; rq < 4; ++rq) { u32x2 w; w.x = cvtpk(o[db][4 * rq] * inv, o[db][4 * rq + 1] * inv); w.y = cvtpk(o[db][4 * rq + 2] * inv, o[db][4 * rq + 3] * inv);
                    *(u32x2*)(PO + 32 * db + 8 * rq + 4 * h) = w; }
            if (h == 0) { float* ML = (float*)(ws + WS_ML) + pi * 2; ML[0] = mrun; ML[1] = lrun; }
        }
    }
    __syncthreads();
}
__device__ __forceinline__ void moba_combine(const Params& P, int lane, int wave, int bid, int G) {
    unsigned char* ws = P.ws;
    const bf16_t* PART = (const bf16_t*)(ws + WS_PART); const float* ML = (const float*)(ws + WS_ML); bf16_t* OA = (bf16_t*)(ws + WS_OA);
    const int gw = bid * 8 + wave, NGW = G * 8, hd = lane >> 3, dc = lane & 7;
    for (int tok = gw; tok < M; tok += NGW) {
        const int b = tok >> 13, q = tok & (SEQ - 1); const size_t base = (size_t)((b * 8 + hd) * 8192 + q) * 4;
        float ms[4], ls[4]; float mx = -1e30f;
#pragma unroll
        for (int s = 0; s < 4; ++s) { const f32x2_t ml = *(const f32x2_t*)(ML + (base + s) * 2); ms[s] = ml[0]; ls[s] = ml[1]; mx = fmaxf(mx, ml[1] > 0.f ? ml[0] : -1e30f); }
        float acc[16]; float wsum = 0.f;
#pragma unroll
        for (int j = 0; j < 16; ++j) acc[j] = 0.f;
#pragma unroll
        for (int s = 0; s < 4; ++s) {
            if (ls[s] > 0.f) { const float w = ls[s] * __builtin_amdgcn_exp2f(ms[s] - mx); wsum += w;
                const u32x4 a = *(const u32x4*)(PART + (base + s) * 128 + 16 * dc), c = *(const u32x4*)(PART + (base + s) * 128 + 16 * dc + 8);
                acc[0] += w * bflo(a.x); acc[1] += w * bfhi(a.x); acc[2] += w * bflo(a.y); acc[3] += w * bfhi(a.y); acc[4] += w * bflo(a.z); acc[5] += w * bfhi(a.z); acc[6] += w * bflo(a.w); acc[7] += w * bfhi(a.w);
                acc[8] += w * bflo(c.x); acc[9] += w * bfhi(c.x); acc[10] += w * bflo(c.y); acc[11] += w * bfhi(c.y); acc[12] += w * bflo(c.z); acc[13] += w * bfhi(c.z); acc[14] += w * bflo(c.w); acc[15] += w * bfhi(c.w); } }
        const float inv = 1.0f / wsum;
        u32x4 o0, o1;
        o0.x = cvtpk(acc[0] * inv, acc[1] * inv); o0.y = cvtpk(acc[2] * inv, acc[3] * inv); o0.z = cvtpk(acc[4] * inv, acc[5] * inv); o0.w = cvtpk(acc[6] * inv, acc[7] * inv);
        o1.x = cvtpk(acc[8] * inv, acc[9] * inv); o1.y = cvtpk(acc[10] * inv, acc[11] * inv); o1.z = cvtpk(acc[12] * inv, acc[13] * inv); o1.w = cvtpk(acc[14] * inv, acc[15] * inv);
        bf16_t* op = OA + (size_t)tok * 2048 + 128 * hd + 16 * dc;
        *(u32x4*)op = o0; *(u32x4*)(op + 8) = o1;
    }
}

__device__ __forceinline__ void p8_router(const Params& P, ldsp lds, int tid, int lane, int wave, int bid, int G) {
    unsigned char* ws = P.ws;
    LAS float* WR = (LAS float*)lds;
    for (int idx = tid; idx < 32768; idx += 512) { const int c = idx >> 5, e = idx & 31; WR[e * 1024 + c] = P.w_router[idx]; }
    LAS int* LH = (LAS int*)(lds + LH_OFF); LAS int* LBASE = (LAS int*)(lds + LBASE_OFF);
    if (tid < 32) LH[tid] = 0;
    __syncthreads();
    const float* X1 = (const float*)(ws + WS_X1); const float* CO = (const float*)(ws + WS_COEF); unsigned char* H = ws + WS_H;
    const int gw = bid * 8 + wave, NGW = G * 8;
    int rec_e = 0, rec_r = 0, rec_m = -1; float rec_w = 0.f;
    int it = 0;
    for (int m = gw; m < M; m += NGW, ++it) {
        const int b = m >> 13;
        const f32x4* xr = (const f32x4*)(X1 + (size_t)m * 1024) + lane;
        f32x4 v[4]; float ss = 0.f;
#pragma unroll
        for (int j = 0; j < 4; ++j) { v[j] = xr[64 * j]; ss += (v[j][0] * v[j][0] + v[j][1] * v[j][1]) + (v[j][2] * v[j][2] + v[j][3] * v[j][3]); }
        const float rstd = 1.0f / sqrtf(wave_sum(ss) * (1.0f / 1024.0f) + RMS_EPS);
#pragma unroll
        for (int j = 0; j < 4; ++j) { const f32x4 a = *(const f32x4*)(CO + (b * 2 + 0) * 1024 + 4 * lane + 256 * j), bb = *(const f32x4*)(CO + (b * 2 + 1) * 1024 + 4 * lane + 256 * j);
            v[j] = v[j] * rstd * a + bb;
            int w = __builtin_amdgcn_cvt_pk_fp8_f32(v[j][0] * H2_SCALE, v[j][1] * H2_SCALE, 0, false); w = __builtin_amdgcn_cvt_pk_fp8_f32(v[j][2] * H2_SCALE, v[j][3] * H2_SCALE, w, true);
            *(int*)(H + (size_t)m * 1024 + 4 * lane + 256 * j) = w; }
        float lg[32];
#pragma unroll
        for (int e = 0; e < 32; ++e) { float a = 0.f;
#pragma unroll
            for (int j = 0; j < 4; ++j) { const f32x4 wv = *(const LAS f32x4*)(WR + e * 1024 + 4 * lane + 256 * j); a += (v[j][0] * wv[0] + v[j][1] * wv[1]) + (v[j][2] * wv[2] + v[j][3] * wv[3]); }
            lg[e] = wave_sum(a) + P.b_router[e]; }
        unsigned used = 0u; int te[4]; float tl[4];
#pragma unroll
        for (int k = 0; k < 4; ++k) { float best = -INFINITY; int be = 0;
#pragma unroll
            for (int e = 0; e < 32; ++e) { const bool ok = !((used >> e) & 1u); if (ok && lg[e] > best) { best = lg[e]; be = e; } }
            used |= 1u << be; te[k] = be; tl[k] = best; }
        const float e1 = __expf(tl[1] - tl[0]), e2 = __expf(tl[2] - tl[0]), e3 = __expf(tl[3] - tl[0]); const float isum = 1.0f / (1.0f + e1 + e2 + e3);
        const float tw[4] = {isum, e1 * isum, e2 * isum, e3 * isum};
        if ((lane >> 2) == it) { const int k = lane & 3; rec_e = k == 0 ? te[0] : k == 1 ? te[1] : k == 2 ? te[2] : te[3]; rec_w = k == 0 ? tw[0] : k == 1 ? tw[1] : k == 2 ? tw[2] : tw[3]; rec_m = m;
            rec_r = __hip_atomic_fetch_add(LH + rec_e, 1, __ATOMIC_RELAXED, __HIP_MEMORY_SCOPE_WORKGROUP); }
    }
    __syncthreads();
    if (tid < 32) LBASE[tid] = (int)atomicAdd((unsigned*)(ws + WS_CTL) + CW_CNT + 64 * tid, (unsigned)LH[tid]);
    __syncthreads();
    if (rec_m >= 0) { const int k = lane & 3; int* TOPE = (int*)(ws + WS_ROUTE); float* TOPW = (float*)(ws + WS_ROUTE + 256 * 1024); int* RANK = (int*)(ws + WS_ROUTE + 512 * 1024);
        TOPE[rec_m * 4 + k] = rec_e; TOPW[rec_m * 4 + k] = rec_w; RANK[rec_m * 4 + k] = LBASE[rec_e] + rec_r; }
}

__device__ __forceinline__ void p9_layout(const Params& P, ldsp lds, int tid) {
    LAS int* TEXP = (LAS int*)(lds + TEXP_OFF); LAS int* EST = (LAS int*)(lds + ESTART_OFF);
    if (tid == 0) { int acc = 0; const unsigned* cnt = (const unsigned*)(P.ws + WS_CTL) + CW_CNT;
        for (int e = 0; e < 32; ++e) { const int c = (int)__hip_atomic_load(cnt + 64 * e, __ATOMIC_RELAXED, __HIP_MEMORY_SCOPE_AGENT); const int pad = (c + 255) & ~255; EST[e] = acc;
            for (int t = acc >> 8; t < (acc + pad) >> 8; ++t) TEXP[t] = e; acc += pad; }
        EST[32] = acc; }
    __syncthreads();
}
__device__ __forceinline__ void p9_gather(const Params& P, ldsp lds, int tid, int lane, int wave, int bid, int G) {
    unsigned char* ws = P.ws;
    const LAS int* EST = (const LAS int*)(lds + ESTART_OFF);
    const int* TOPE = (const int*)(ws + WS_ROUTE); const int* RANK = (const int*)(ws + WS_ROUTE + 512 * 1024); int* POS = (int*)(ws + WS_ROUTE + 768 * 1024);
    const unsigned char* H = ws + WS_H; unsigned char* XP = ws + WS_XP;
    const int gw = bid * 8 + wave, NGW = G * 8;
    for (int m = gw; m < M; m += NGW) {
        int pos = 0;
        if (lane < 4) { pos = EST[TOPE[m * 4 + lane]] + RANK[m * 4 + lane]; POS[m * 4 + lane] = pos; }
        const u32x4 a = *(const u32x4*)(H + (size_t)m * 1024 + 16 * lane);
#pragma unroll
        for (int k = 0; k < 4; ++k) { const int pk = __shfl(pos, k); *(u32x4*)(XP + (size_t)pk * 1024 + 16 * lane) = a; }
    }
}

__device__ __forceinline__ void p12_final(const Params& P, int lane, int wave, int bid, int G) {
    unsigned char* ws = P.ws;
    const float* X1 = (const float*)(ws + WS_X1); const float* MOD = (const float*)(ws + WS_MOD); const bf16_t* YS = (const bf16_t*)(ws + WS_YS);
    const float* TOPW = (const float*)(ws + WS_ROUTE + 256 * 1024); const int* POS = (const int*)(ws + WS_ROUTE + 768 * 1024);
    const int gw = bid * 8 + wave, NGW = G * 8;
    for (int m = gw; m < M; m += NGW) {
        const int b = m >> 13;
        int pos = 0; float wt = 0.f;
        if (lane < 4) { pos = POS[m * 4 + lane]; wt = TOPW[m * 4 + lane]; }
        const f32x4* xr = (const f32x4*)(X1 + (size_t)m * 1024) + lane;
        f32x4 v[4], acc[4];
#pragma unroll
        for (int j = 0; j < 4; ++j) { v[j] = xr[64 * j]; acc[j] = (f32x4){0.f, 0.f, 0.f, 0.f}; }
#pragma unroll
        for (int k = 0; k < 4; ++k) { const int pk = __shfl(pos, k); const float wk = __shfl(wt, k);
#pragma unroll
            for (int j = 0; j < 4; ++j) { const u32x2 y = *(const u32x2*)(YS + (size_t)pk * 1024 + 4 * lane + 256 * j);
                acc[j][0] += wk * bflo(y.x); acc[j][1] += wk * bfhi(y.x); acc[j][2] += wk * bflo(y.y); acc[j][3] += wk * bfhi(y.y); } }
        float ss = 0.f;
#pragma unroll
        for (int j = 0; j < 4; ++j) { const f32x4 g2 = *(const f32x4*)(MOD + b * 6144 + 5120 + 4 * lane + 256 * j); v[j] = v[j] + g2 * acc[j];
            ss += (v[j][0] * v[j][0] + v[j][1] * v[j][1]) + (v[j][2] * v[j][2] + v[j][3] * v[j][3]); }
        const float rstd = 1.0f / sqrtf(wave_sum(ss) * (1.0f / 1024.0f) + RMS_EPS);
#pragma unroll
        for (int j = 0; j < 4; ++j) { const f32x4 fw = *(const f32x4*)(P.final_norm_w + 4 * lane + 256 * j); *((f32x4*)(P.out + (size_t)m * 1024) + lane + 64 * j) = v[j] * rstd * fw; }
    }
}

#ifndef REPMASK
#define REPMASK 0
#endif
#define REPN(i) (((REPMASK >> (i)) & 1) + 1)
#define XBAR() do { xcd_barrier(bar); if (REPN(15) > 1) xcd_barrier(bar); } while (0)
__global__ void __launch_bounds__(512, 2) mk_fwd(Params P) {
    extern __shared__ __attribute__((aligned(16))) unsigned char lds_raw[];
    ldsp lds = (ldsp)lds_raw;
    const int tid = threadIdx.x, lane = tid & 63, wave = __builtin_amdgcn_readfirstlane(tid >> 6);
    const int bid = blockIdx.x, G = gridDim.x;
    unsigned char* ws = P.ws;
    for (int u = tid; u < (LDS_BYTES - LDSCTL_OFF) / 4; u += 512) ((LAS unsigned*)(lds + LDSCTL_OFF))[u] = 0u;
    __syncthreads();
    volatile LAS unsigned* MISC = (volatile LAS unsigned*)(lds + MISC_OFF);
    XcdBarrier bar = xcd_barrier_post((unsigned*)(ws + WS_CTL) + CW_BAR, MISC + 8);

#if !defined(PHMASK) || ((PHMASK >> 0) & 1)
    for (int rep_ = 0; rep_ < REPN(0); ++rep_) {
    p0_prologue(P, lds, tid, lane, wave, bid, G);
    }
    XBAR();
#endif
#if !defined(PHMASK) || ((PHMASK >> 1) & 1)
    for (int rep_ = 0; rep_ < REPN(1); ++rep_) {
    p1_norm1(P, lds, tid, lane, wave, bid, G);
    }
    XBAR();
#endif
#if !defined(PHMASK) || ((PHMASK >> 2) & 1)
    {
        pg8::Gemm g{(const pg8::bf16_t*)(ws + WS_H), (const pg8::bf16_t*)(ws + WS_WIN), M, NMAIN, 1024, 0, 0}; pg8::StaticOrder S; S.init(M, NMAIN, G, bid, REPN(2));
        pg8::EpiInProj E{ws, P.b_merge};
        pg8::gemm_phase<pg8::EpiInProj, pg8::StaticOrder, true, true>(lds, g, S, E);
    }
    {
        pg8::Gemm g{(const pg8::bf16_t*)(ws + WS_WV), (const pg8::bf16_t*)(ws + WS_H), 1024, M, 1024, 0, 0}; pg8::StaticOrder S; S.init(1024, M, G, bid, REPN(2));
        pg8::EpiBf16<0> E{(pg8::bf16_t*)(ws + WS_VT), M, nullptr, 0, 0, 1.f};
        pg8::gemm_phase<pg8::EpiBf16<0>, pg8::StaticOrder, true, true>(lds, g, S, E);
    }
    XBAR();
#endif
#if !defined(PHMASK) || ((PHMASK >> 3) & 1)
    for (int rep_ = 0; rep_ < REPN(3); ++rep_) {
    for (int item = bid; item < 512; item += G) kmean_item(P, lds, item, tid);
    for (int u = bid; u < 256; u += G) gla_unit<false>(P, lds, u >> 5, u & 31, tid, lane, wave);
    }
    XBAR();
#endif
#if !defined(PHMASK) || ((PHMASK >> 4) & 1)
    for (int rep_ = 0; rep_ < REPN(4); ++rep_) {
    if (bid * 512 + tid < 131072) gla_scan(P, tid, bid);
    }
    for (int u = bid; u < 512; u += G) moba_select_unit(P, lds, u >> 8, (u >> 5) & 7, u & 31, tid, lane, wave);
    XBAR();
#endif
#if !defined(PHMASK) || ((PHMASK >> 5) & 1)
    {
        moba_item_table(P, lds, lane, wave);
        volatile LAS int* QI = (volatile LAS int*)(lds + QI_OFF);
        const int NATT = ((const LAS int*)(lds + IPFX_OFF))[512]; const int NG = 256 * REPN(13); const int total = NG + NATT * REPN(5);
        for (;;) {
            if (tid == 0) QI[0] = (int)atomicAdd((unsigned*)(ws + WS_CTL) + CW_QHEAD, 1u);
            __syncthreads();
            const int it = __builtin_amdgcn_readfirstlane(QI[0]);
            __syncthreads();
            if (it >= total) break;
            if (it < NG) gla_unit<true>(P, lds, (it & 255) >> 5, it & 31, tid, lane, wave);
            else moba_item(P, lds, (it - NG) % NATT, tid, wave);
        }
    }
    XBAR();
    moba_combine(P, lane, wave, bid, G);
    XBAR();
#endif
#if !defined(PHMASK) || ((PHMASK >> 6) & 1)
    {
        pg8::Gemm g{(const pg8::bf16_t*)(ws + WS_OA), (const pg8::bf16_t*)(ws + WS_WOA), M, 1024, 2048, 0, 0}; pg8::StaticOrder S; S.init(M, 1024, G, bid, REPN(6));
        pg8::EpiMerge2 E{(const bf16_t*)(ws + WS_GA), (const bf16_t*)(ws + WS_GB), (bf16_t*)(ws + WS_MERGED)};
        pg8::gemm_phase<pg8::EpiMerge2, pg8::StaticOrder, true, true>(lds, g, S, E);
    }
    XBAR();
#endif
#if !defined(PHMASK) || ((PHMASK >> 7) & 1)
    {
        pg8::Gemm g{(const pg8::bf16_t*)(ws + WS_MERGED), (const pg8::bf16_t*)(ws + WS_WOUT), M, 1024, 1024, 0, 0}; pg8::StaticOrder S; S.init(M, 1024, G, bid, REPN(7));
        pg8::EpiX1 E{P.x, (const float*)(ws + WS_MOD), (float*)(ws + WS_X1)};
        pg8::gemm_phase<pg8::EpiX1, pg8::StaticOrder, true, true>(lds, g, S, E);
    }
    XBAR();
#endif
#if !defined(PHMASK) || ((PHMASK >> 8) & 1)
    for (int rep_ = 0; rep_ < REPN(8); ++rep_) {
    p8_router(P, lds, tid, lane, wave, bid, G);
    }
    XBAR();
#endif
#if !defined(PHMASK) || ((PHMASK >> 9) & 1)
    for (int rep_ = 0; rep_ < REPN(9); ++rep_) {
    p9_layout(P, lds, tid);
    p9_gather(P, lds, tid, lane, wave, bid, G);
    }
    XBAR();
#endif
#if !defined(PHMASK) || ((PHMASK >> 10) & 1)
    {
        pg8::Gemm g{(const pg8::bf16_t*)(ws + WS_XP), (const pg8::bf16_t*)(ws + WS_WE1), PT_MAX * 256, 2048, 512, SC_H2, SC_WE};
        pg8::GroupedOrder S{8, G, bid, (const LAS int*)(lds + TEXP_OFF), (const LAS int*)(lds + ESTART_OFF), (size_t)2048 * 1024, REPN(10)};
        pg8::EpiMoE1 E{P.b_exp_in, ws + WS_ACT};
        pg8::gemm_phase<pg8::EpiMoE1, pg8::GroupedOrder, true, true, true>(lds, g, S, E);
    }
    XBAR();
#endif
#if !defined(PHMASK) || ((PHMASK >> 11) & 1)
    {
        pg8::Gemm g{(const pg8::bf16_t*)(ws + WS_ACT), (const pg8::bf16_t*)(ws + WS_WE2), PT_MAX * 256, 1024, 512, SC_ACT, SC_WE};
        pg8::GroupedOrder S{4, G, bid, (const LAS int*)(lds + TEXP_OFF), (const LAS int*)(lds + ESTART_OFF), (size_t)1024 * 1024, REPN(11)};
        pg8::EpiMoE2 E{P.b_exp_out, (bf16_t*)(ws + WS_YS)};
        pg8::gemm_phase<pg8::EpiMoE2, pg8::GroupedOrder, true, true, true>(lds, g, S, E);
    }
    XBAR();
#endif
#if !defined(PHMASK) || ((PHMASK >> 12) & 1)
    for (int rep_ = 0; rep_ < REPN(12); ++rep_) {
    p12_final(P, lane, wave, bid, G);
    }
#endif
}

extern "C" void kernel_launch(void* const* d_in, const int* in_sizes, int n_in, void* d_out, int out_size, void* d_ws, size_t ws_size, hipStream_t stream) {
    static int grid = 0;
    if (grid == 0) {
        if (n_in != 21 || in_sizes[0] != M * D || out_size != M * D || ws_size < WS_END) { fprintf(stderr, "kernel_launch: unexpected shapes (n_in %d, in0 %d, out %d, ws %zu); nothing launched\n", n_in, n_in > 0 ? in_sizes[0] : -1, out_size, ws_size); grid = -1; return; }
        int dev = 0, cus = 0, per_cu = 0;
        if (hipGetDevice(&dev) != hipSuccess || hipDeviceGetAttribute(&cus, hipDeviceAttributeMultiprocessorCount, dev) != hipSuccess) { grid = -1; return; }
        if (hipFuncSetAttribute((const void*)mk_fwd, hipFuncAttributeMaxDynamicSharedMemorySize, LDS_BYTES) != hipSuccess) { fprintf(stderr, "kernel_launch: hipFuncSetAttribute failed\n"); grid = -1; return; }
        if (hipOccupancyMaxActiveBlocksPerMultiprocessor(&per_cu, (const void*)mk_fwd, 512, LDS_BYTES) != hipSuccess || per_cu < 1) { fprintf(stderr, "kernel_launch: occupancy query says %d workgroups per CU; nothing launched\n", per_cu); (void)hipGetLastError(); grid = -1; return; }
        grid = cus;
    }
    if (grid < 0) return;
    (void)hipMemsetAsync((char*)d_ws + WS_CTL, 0, CTL_ZERO_BYTES, stream);
    Params p{};
    const float** pp = (const float**)&p;
    for (int i = 0; i < 21; ++i) pp[i] = (const float*)d_in[i];
    p.out = (float*)d_out; p.ws = (unsigned char*)d_ws;
    void* args[] = {&p};
    hipError_t e = hipLaunchCooperativeKernel((const void*)mk_fwd, dim3(grid), dim3(512), args, LDS_BYTES, stream);
    if (e != hipSuccess) fprintf(stderr, "kernel_launch: cooperative launch failed: %s (grid %d)\n", hipGetErrorString(e), grid);
}
```
